# Optimizing an MI355X kernel written in HIP

```python
import math
import jax, jax.numpy as jnp
from jax import lax
import numpy as np

D_MODEL = 1024
BATCH = 1
SEQ = 16384
DEPTH = 2

HEAD_DIM = 64
FOX_HEADS = 8
FOX_WIDTH = FOX_HEADS * HEAD_DIM
DIFF_HEADS = 4
DIFF_QK_WIDTH = DIFF_HEADS * 2 * HEAD_DIM
DIFF_V_DIM = 2 * HEAD_DIM
DIFF_V_WIDTH = DIFF_HEADS * DIFF_V_DIM
IN_SPLIT_SIZES = (FOX_WIDTH, FOX_WIDTH, FOX_WIDTH, FOX_HEADS, DIFF_QK_WIDTH, DIFF_QK_WIDTH, DIFF_V_WIDTH, D_MODEL, D_MODEL)
IN_SPLIT_POINTS = tuple(int(p) for p in np.cumsum(IN_SPLIT_SIZES)[:-1])
N_IN = int(sum(IN_SPLIT_SIZES))
FOX_V_OFFSET = 2 * FOX_WIDTH
DIFF_V_OFFSET = 3 * FOX_WIDTH + FOX_HEADS + 2 * DIFF_QK_WIDTH
BLOCK_Q = 128
REL_BUCKETS = 32
REL_MAX_DISTANCE = 128
FGATE_BIAS_INIT = 3.0
D_FF = 2816
N_EXPERTS = 8
TOP_K = 2
D_FF_EXPERT = 3584
LN_EPS = 1e-5
SUBLN_EPS = 1e-5
DEEPNORM_ALPHA = (2.0 * DEPTH) ** 0.25
DEEPNORM_BETA = (8.0 * DEPTH) ** -0.25
N_DENSE = (DEPTH + 1) // 2
N_MOE = DEPTH // 2

kernel_name = 'hybrid_fox_diffattn_deepnorm_moe'


def layer_norm(x, g, b):
    x32 = x.astype(jnp.float32)
    mu = jnp.mean(x32, axis=-1, keepdims=True)
    xc = x32 - mu
    var = jnp.mean(xc * xc, axis=-1, keepdims=True)
    y = xc * lax.rsqrt(var + LN_EPS) * g.astype(jnp.float32) + b.astype(jnp.float32)
    return y.astype(x.dtype)


def t5_causal_bucket(dist):
    n = jnp.maximum(dist, 0)
    max_exact = REL_BUCKETS // 2
    nf = jnp.maximum(n, 1).astype(jnp.float32)
    log_part = jnp.log(nf / max_exact) / math.log(REL_MAX_DISTANCE / max_exact) * (REL_BUCKETS - max_exact)
    large = jnp.minimum(max_exact + log_part.astype(jnp.int32), REL_BUCKETS - 1)
    return jnp.where(n < max_exact, n, large)


def fox_attention(q, k, v, log_f):
    B, S, H, Dh = q.shape
    nb = S // BLOCK_Q
    scale = Dh ** -0.5
    cum = jnp.cumsum(log_f.astype(jnp.float32), axis=1)
    cum_k = jnp.transpose(cum, (0, 2, 1))
    kpos = jnp.arange(S)
    qb = jnp.moveaxis(q.reshape(B, nb, BLOCK_Q, H, Dh), 1, 0)
    cb = jnp.moveaxis(cum_k.reshape(B, H, nb, BLOCK_Q), 2, 0)

    def block(args):
        i, qi, ci = args
        qpos = i * BLOCK_Q + jnp.arange(BLOCK_Q)
        s = jnp.einsum('bqhd,bkhd->bhqk', qi, k, preferred_element_type=jnp.float32) * scale
        s = s + ci[..., :, None] - cum_k[:, :, None, :]
        s = jnp.where(kpos[None, :] <= qpos[:, None], s, -jnp.inf)
        p = jax.nn.softmax(s, axis=-1)
        return jnp.einsum('bhqk,bkhd->bqhd', p.astype(v.dtype), v, preferred_element_type=jnp.float32)

    out = lax.map(block, (jnp.arange(nb), qb, cb))
    return jnp.moveaxis(out, 0, 1).reshape(B, S, H, Dh)


def diff_attention(q, k, v, lam, rel_bias):
    B, S, H, _, Dh = q.shape
    nb = S // BLOCK_Q
    scale = Dh ** -0.5
    kpos = jnp.arange(S)
    table = rel_bias.astype(jnp.float32)
    qb = jnp.moveaxis(q.reshape(B, nb, BLOCK_Q, H, 2, Dh), 1, 0)

    def block(args):
        i, qi = args
        qpos = i * BLOCK_Q + jnp.arange(BLOCK_Q)
        dist = qpos[:, None] - kpos[None, :]
        bias = jnp.moveaxis(table[t5_causal_bucket(dist)], -1, 0)
        s = jnp.einsum('bqhcd,bkhcd->bhcqk', qi, k, preferred_element_type=jnp.float32) * scale
        s = s + bias[None, :, None]
        s = jnp.where(dist >= 0, s, -jnp.inf)
        p = jax.nn.softmax(s, axis=-1)
        a = p[:, :, 0] - lam * p[:, :, 1]
        return jnp.einsum('bhqk,bkhe->bqhe', a.astype(v.dtype), v, preferred_element_type=jnp.float32)

    out = lax.map(block, (jnp.arange(nb), qb))
    return jnp.moveaxis(out, 0, 1).reshape(B, S, H, v.shape[-1])


def token_mixer(u, w_in, b_f, lq1, lk1, lq2, lk2, subln_g, w_br_fox, w_br_diff, w_out, rel_bias, lam_init):
    B, S, _ = u.shape
    f32 = jnp.float32
    proj = jnp.einsum('bsd,dn->bsn', u, w_in)
    fq, fk, fv, fg, dq, dk, dv, ga, gb = jnp.split(proj, IN_SPLIT_POINTS, axis=-1)
    log_f = jax.nn.log_sigmoid(fg.astype(f32) + b_f.astype(f32))
    y_fox = fox_attention(fq.reshape(B, S, FOX_HEADS, HEAD_DIM), fk.reshape(B, S, FOX_HEADS, HEAD_DIM),
                          fv.reshape(B, S, FOX_HEADS, HEAD_DIM), log_f)
    y_fox = y_fox.reshape(B, S, FOX_WIDTH).astype(u.dtype)
    lam = (jnp.exp(jnp.sum(lq1.astype(f32) * lk1.astype(f32)))
           - jnp.exp(jnp.sum(lq2.astype(f32) * lk2.astype(f32))) + lam_init)
    o = diff_attention(dq.reshape(B, S, DIFF_HEADS, 2, HEAD_DIM), dk.reshape(B, S, DIFF_HEADS, 2, HEAD_DIM),
                       dv.reshape(B, S, DIFF_HEADS, DIFF_V_DIM), lam, rel_bias)
    o = o * lax.rsqrt(jnp.mean(o * o, axis=-1, keepdims=True) + SUBLN_EPS) * subln_g.astype(f32) * (1.0 - lam_init)
    y_diff = o.reshape(B, S, DIFF_V_WIDTH).astype(u.dtype)
    branch_fox = y_fox @ w_br_fox
    branch_diff = y_diff @ w_br_diff
    merged = jax.nn.sigmoid(ga) * branch_fox + jax.nn.sigmoid(gb) * branch_diff
    return merged @ w_out


def swiglu(x, w_gate_up, w_down):
    g, up = jnp.split(x @ w_gate_up, 2, axis=-1)
    return (jax.nn.silu(g) * up) @ w_down


def moe_swiglu(x, w_router, w_gate_up, w_down):
    logits = (x @ w_router).astype(jnp.float32)
    top_v, top_i = lax.top_k(logits, TOP_K)
    gates = jax.nn.softmax(top_v, axis=-1)
    combine = jnp.sum(jax.nn.one_hot(top_i, N_EXPERTS, dtype=jnp.float32) * gates[..., None], axis=-2)
    y = jnp.zeros_like(x)
    for e in range(N_EXPERTS):
        y = y + combine[..., e:e + 1].astype(x.dtype) * swiglu(x, w_gate_up[e], w_down[e])
    return y


def setup_inputs(seed: int = 0) -> dict:
    key = jax.random.key(seed)
    ks = jax.random.split(key, 32)
    f32 = jnp.float32

    def nrm(k, shape, scale):
        return jax.random.normal(k, shape, f32) * scale

    col_scale = np.ones((N_IN,), np.float32)
    col_scale[FOX_V_OFFSET:FOX_V_OFFSET + FOX_WIDTH] = DEEPNORM_BETA
    col_scale[DIFF_V_OFFSET:DIFF_V_OFFSET + DIFF_V_WIDTH] = DEEPNORM_BETA
    w_in = nrm(ks[3], (DEPTH, D_MODEL, N_IN), D_MODEL ** -0.5) * jnp.asarray(col_scale)
    return {
        'x': nrm(ks[0], (BATCH, SEQ, D_MODEL), 1.0),
        'ln_in_g': 1.0 + nrm(ks[1], (D_MODEL,), 0.02),
        'ln_in_b': nrm(ks[2], (D_MODEL,), 0.02),
        'w_in': w_in,
        'b_fgate': FGATE_BIAS_INIT + nrm(ks[4], (DEPTH, FOX_HEADS), 0.5),
        'lam_q1': nrm(ks[5], (DEPTH, HEAD_DIM), 0.1),
        'lam_k1': nrm(ks[6], (DEPTH, HEAD_DIM), 0.1),
        'lam_q2': nrm(ks[7], (DEPTH, HEAD_DIM), 0.1),
        'lam_k2': nrm(ks[8], (DEPTH, HEAD_DIM), 0.1),
        'subln_g': 1.0 + nrm(ks[9], (DEPTH, DIFF_V_DIM), 0.02),
        'w_branch_fox': nrm(ks[10], (DEPTH, FOX_WIDTH, D_MODEL), FOX_WIDTH ** -0.5 * DEEPNORM_BETA),
        'w_branch_diff': nrm(ks[11], (DEPTH, DIFF_V_WIDTH, D_MODEL), DIFF_V_WIDTH ** -0.5 * DEEPNORM_BETA),
        'w_out': nrm(ks[12], (DEPTH, D_MODEL, D_MODEL), D_MODEL ** -0.5 * DEEPNORM_BETA),
        'ln_mix_g': 1.0 + nrm(ks[13], (DEPTH, D_MODEL), 0.02),
        'ln_mix_b': nrm(ks[14], (DEPTH, D_MODEL), 0.02),
        'rel_bias': nrm(ks[15], (REL_BUCKETS, DIFF_HEADS), 0.5),
        'w_ffn_gate_up': nrm(ks[16], (N_DENSE, D_MODEL, 2 * D_FF), D_MODEL ** -0.5 * DEEPNORM_BETA),
        'w_ffn_down': nrm(ks[17], (N_DENSE, D_FF, D_MODEL), D_FF ** -0.5 * DEEPNORM_BETA),
        'w_router': nrm(ks[18], (N_MOE, D_MODEL, N_EXPERTS), D_MODEL ** -0.5),
        'w_expert_gate_up': nrm(ks[19], (N_MOE, N_EXPERTS, D_MODEL, 2 * D_FF_EXPERT), D_MODEL ** -0.5 * DEEPNORM_BETA),
        'w_expert_down': nrm(ks[20], (N_MOE, N_EXPERTS, D_FF_EXPERT, D_MODEL), D_FF_EXPERT ** -0.5 * DEEPNORM_BETA),
        'ln_ffn_g': 1.0 + nrm(ks[21], (DEPTH, D_MODEL), 0.02),
        'ln_ffn_b': nrm(ks[22], (DEPTH, D_MODEL), 0.02),
    }


def reference(x, ln_in_g, ln_in_b, w_in, b_fgate, lam_q1, lam_k1, lam_q2, lam_k2, subln_g,
              w_branch_fox, w_branch_diff, w_out, ln_mix_g, ln_mix_b, rel_bias,
              w_ffn_gate_up, w_ffn_down, w_router, w_expert_gate_up, w_expert_down,
              ln_ffn_g, ln_ffn_b):
    h = layer_norm(x, ln_in_g, ln_in_b)
    for l in range(DEPTH):
        lam_init = 0.8 - 0.6 * math.exp(-0.3 * l)
        mix = token_mixer(h, w_in[l], b_fgate[l], lam_q1[l], lam_k1[l], lam_q2[l], lam_k2[l], subln_g[l],
                          w_branch_fox[l], w_branch_diff[l], w_out[l], rel_bias, lam_init)
        h = layer_norm(DEEPNORM_ALPHA * h + mix, ln_mix_g[l], ln_mix_b[l])
        if l % 2 == 0:
            f = swiglu(h, w_ffn_gate_up[l // 2], w_ffn_down[l // 2])
        else:
            f = moe_swiglu(h, w_router[l // 2], w_expert_gate_up[l // 2], w_expert_down[l // 2])
        h = layer_norm(DEEPNORM_ALPHA * h + f, ln_ffn_g[l], ln_ffn_b[l])
    return h
```

```cpp
#include <hip/hip_runtime.h>
#include <hip/hip_cooperative_groups.h>
#include <hip/hip_bf16.h>
#include <cstdio>
#include <cstdint>
#include <cmath>
namespace cg = cooperative_groups;
namespace pg8 {
#define PG8_LAS __attribute__((address_space(3)))
typedef unsigned short bf16_t;
typedef short bf16x8 __attribute__((ext_vector_type(8)));
typedef float f32x4 __attribute__((ext_vector_type(4)));
typedef unsigned u32x4 __attribute__((ext_vector_type(4)));
constexpr int BM = 256, BK = 64, HALF = 128, HTB = HALF * BK * 2  , STAGE_BYTES = 8 * HTB, NXCD = 8, WGM = 8;

__host__ __device__ __forceinline__ int lds_byte(int r, int c) { const int st = (r >> 4) * 2 + (c >> 5), rr = r & 15, cc = c & 31, ob = rr * 64 + cc * 2; return st * 1024 + (ob ^ (((ob >> 9) & 1) << 5)); }
__host__ __device__ __forceinline__ void stage_rc(int b, int& R, int& C) { const int st = b / 1024, sb = b % 1024, swz = sb ^ (((sb >> 9) & 1) << 5); R = (st >> 1) * 16 + swz / 64; C = (st & 1) * 32 + (swz % 64) / 2; }
__host__ __device__ __forceinline__ int perm32(int rho) { const int n = rho >> 4, i = rho & 15; return 8 * (i >> 2) + 4 * n + (i & 3); }

struct Unit { int pm, pn; int koff = 0; int aux = 0; };
struct Gemm { const bf16_t* A; const bf16_t* Bt; int M, N, K; int ld = 0; };

struct StaticOrder {
    int nM, nN, nwg, G, c;
    __host__ __device__ void init(int M, int N, int G_, int c_) { nM = M / BM; nN = N / BM; nwg = nM * nN; G = G_; c = c_; }
    __host__ __device__ bool next(int i, Unit& u) const {
        const long L = (long)i * G + c; if (L >= nwg) return false;
        int wgid = (int)L; { const int q = nwg / NXCD, r = nwg % NXCD, xcd = wgid % NXCD, off = wgid / NXCD; wgid = (xcd < r ? xcd * (q + 1) : r * (q + 1) + (xcd - r) * q) + off; }
        const int nig = WGM * nN, gid = wgid / nig, fm = gid * WGM, gsz = (nM - fm) < WGM ? (nM - fm) : WGM;
        u.pm = fm + ((wgid % nig) % gsz); u.pn = (wgid % nig) / gsz; return true;
    }
    __device__ __forceinline__ void a_ready(const Unit&) const {}
    __device__ __forceinline__ void done(const Unit&) const {}
};

__device__ __forceinline__ unsigned cvt_pk_bf16(float lo, float hi) { unsigned r; asm volatile("v_cvt_pk_bf16_f32 %0, %1, %2" : "=v"(r) : "v"(lo), "v"(hi)); return r; }
__device__ __forceinline__ float sigm(float x) { return __builtin_amdgcn_rcpf(1.f + __builtin_amdgcn_exp2f(-1.4426950408889634f * x)); }
__device__ __forceinline__ float bf_lo(unsigned w) { return __uint_as_float(w << 16); }
__device__ __forceinline__ float bf_hi(unsigned w) { return __uint_as_float(w & 0xffff0000u); }
constexpr int NPROJ = 5120, M_ROWS = 16384;
struct EpiProj {
    static constexpr bool PERM = true, AFTER_DRAIN = false;
    bf16_t* O; float qscale; unsigned* nrm;
    __device__ __forceinline__ void operator()(const f32x4 (&acc)[2][2][4][2], const Unit& u, int wr, int wc, int fr, int fq) const {
        const int pn = u.pn; const float sc = (pn < 2 || (pn >= 6 && pn < 8)) ? qscale : 1.f; const bool gate = pn >= 12;
        const int row0 = u.pm * BM + wr * 64 + fr;
        const int seg = pn >> 1;
#pragma unroll
        for (int ai = 0; ai < 2; ++ai)
#pragma unroll
            for (int m = 0; m < 4; ++m) { const size_t row = (size_t)(row0 + ai * HALF + m * 16);
#pragma unroll
                for (int bj = 0; bj < 2; ++bj) { f32x4 v0 = acc[ai][bj][m][0], v1 = acc[ai][bj][m][1];
                    if (gate) { v0 = (f32x4){sigm(v0[0]), sigm(v0[1]), sigm(v0[2]), sigm(v0[3])}; v1 = (f32x4){sigm(v1[0]), sigm(v1[1]), sigm(v1[2]), sigm(v1[3])}; }
                    else { v0 = v0 * sc; v1 = v1 * sc; }
                    u32x4 w; w.x = cvt_pk_bf16(v0[0], v0[1]); w.y = cvt_pk_bf16(v0[2], v0[3]); w.z = cvt_pk_bf16(v1[0], v1[1]); w.w = cvt_pk_bf16(v1[2], v1[3]);
                    const int g64 = 4 * (pn & 1) + 2 * bj + (wc >> 1), cin = 32 * (wc & 1) + 8 * fq;
                    bf16_t* dst;
                    if (gate) dst = O + (size_t)6 * 512 * M_ROWS + row * 2048 + (pn - 12) * BM + bj * HALF + wc * 32 + 8 * fq;
                    else if (seg == 5) dst = O + (size_t)5 * 512 * M_ROWS + ((size_t)(g64 >> 1) * M_ROWS + row) * 128 + 64 * (g64 & 1) + cin;
                    else dst = O + (size_t)seg * 512 * M_ROWS + ((size_t)g64 * M_ROWS + row) * 64 + cin;
                    *(u32x4*)dst = w; } }
        if (pn < 4) {
            float mx[2] = {0.f, 0.f};
#pragma unroll
            for (int ai = 0; ai < 2; ++ai)
#pragma unroll
                for (int m = 0; m < 4; ++m)
#pragma unroll
                    for (int bj = 0; bj < 2; ++bj) { const f32x4 v0 = acc[ai][bj][m][0] * sc, v1 = acc[ai][bj][m][1] * sc;
                        float ss = (v0[0] * v0[0] + v0[1] * v0[1]) + (v0[2] * v0[2] + v0[3] * v0[3]) + (v1[0] * v1[0] + v1[1] * v1[1]) + (v1[2] * v1[2] + v1[3] * v1[3]);
                        ss += __shfl_xor(ss, 16); ss += __shfl_xor(ss, 32); mx[bj] = fmaxf(mx[bj], ss); }
#pragma unroll
            for (int bj = 0; bj < 2; ++bj) { float v = mx[bj]; v = fmaxf(v, __shfl_xor(v, 1)); v = fmaxf(v, __shfl_xor(v, 2)); v = fmaxf(v, __shfl_xor(v, 4)); v = fmaxf(v, __shfl_xor(v, 8));
                if (fr == 0 && fq == 0) atomicMax(nrm + (pn >> 1) * 16 + (4 * (pn & 1) + 2 * bj + (wc >> 1)) * 2 + (wc & 1), __float_as_uint(v)); }
        }
    }
};
struct EpiMerge {
    static constexpr bool PERM = true, AFTER_DRAIN = false;
    const bf16_t* proj; float* T; bf16_t* merged;
    __device__ __forceinline__ void operator()(const f32x4 (&acc)[2][2][4][2], const Unit& u, int wr, int wc, int fr, int fq) const {
        const bool second = u.pn >= 4; const int pn = second ? u.pn - 4 : u.pn, pm = second ? u.pm - 64 : u.pm;
        const int row0 = pm * BM + wr * 64 + fr, col0 = pn * BM + wc * 32 + 8 * fq; const int goff = second ? 1024 : 0;
#pragma unroll
        for (int ai = 0; ai < 2; ++ai)
#pragma unroll
            for (int m = 0; m < 4; ++m) { const size_t row = (size_t)(row0 + ai * HALF + m * 16);
#pragma unroll
                for (int bj = 0; bj < 2; ++bj) { const int col = col0 + bj * HALF;
                    const u32x4 gw = *(const u32x4*)(proj + (size_t)6 * 512 * M_ROWS + row * 2048 + goff + col);
                    const f32x4 g0 = (f32x4){bf_lo(gw.x), bf_hi(gw.x), bf_lo(gw.y), bf_hi(gw.y)}, g1 = (f32x4){bf_lo(gw.z), bf_hi(gw.z), bf_lo(gw.w), bf_hi(gw.w)};
                    f32x4 v0 = acc[ai][bj][m][0] * g0, v1 = acc[ai][bj][m][1] * g1; bf16_t* mp = merged + row * 1024 + col;
                    if (second) { const u32x4 tw = *(const u32x4*)mp;
                        v0 = v0 + (f32x4){bf_lo(tw.x), bf_hi(tw.x), bf_lo(tw.y), bf_hi(tw.y)}; v1 = v1 + (f32x4){bf_lo(tw.z), bf_hi(tw.z), bf_lo(tw.w), bf_hi(tw.w)}; }
                    u32x4 w; w.x = cvt_pk_bf16(v0[0], v0[1]); w.y = cvt_pk_bf16(v0[2], v0[3]); w.z = cvt_pk_bf16(v1[0], v1[1]); w.w = cvt_pk_bf16(v1[2], v1[3]);
                    *(u32x4*)mp = w; }
                asm volatile("" ::: "memory"); }
    }
};
struct PrevLN { const float* src; const float* stats; const float* g; const float* b; };
struct EpiResid {
    static constexpr bool PERM = false, AFTER_DRAIN = false;
    PrevLN p; float* z; float alpha;
    __device__ __forceinline__ void operator()(const f32x4 (&acc)[2][2][4][2], const Unit& u, int wr, int wc, int fr, int fq) const {
        int row0 = u.pm * BM + wr * 64 + fr, col0 = u.pn * BM + wc * 32 + 4 * fq; asm volatile("" : "+v"(row0), "+v"(col0));
        typedef float f32x2v __attribute__((ext_vector_type(2)));
#pragma unroll
        for (int ai = 0; ai < 2; ++ai)
#pragma unroll
            for (int m = 0; m < 4; ++m) { const int row = row0 + ai * HALF + m * 16; const size_t ro = (size_t)row * 1024 + col0; const f32x2v st = *(const f32x2v*)(p.stats + 2 * row);
#pragma unroll
                for (int bj = 0; bj < 2; ++bj)
#pragma unroll
                    for (int n = 0; n < 2; ++n) { const int c = col0 + bj * HALF + n * 16; const size_t off = ro + bj * HALF + n * 16;
                        const f32x4 sv = *(const f32x4*)(p.src + off), gv = *(const f32x4*)(p.g + c), bv = *(const f32x4*)(p.b + c);
                        const f32x4 hv = (sv - st.x) * st.y * gv + bv; *(f32x4*)(z + off) = hv * alpha + acc[ai][bj][m][n]; }
                asm volatile("" ::: "memory"); }
    }
};
struct EpiSwiglu {
    static constexpr bool PERM = true, AFTER_DRAIN = false;
    bf16_t* O; int ldo; int nper;
    __device__ __forceinline__ void operator()(const f32x4 (&acc)[2][2][4][2], const Unit& u, int wr, int wc, int fr, int fq) const {
        const int pnl = u.pn % nper; const int row0 = u.pm * BM + wr * 64 + fr, col0 = pnl * HALF + wc * 32 + 8 * fq;
#pragma unroll
        for (int ai = 0; ai < 2; ++ai)
#pragma unroll
            for (int m = 0; m < 4; ++m) { const f32x4 g0 = acc[ai][0][m][0], g1 = acc[ai][0][m][1], u0 = acc[ai][1][m][0], u1 = acc[ai][1][m][1]; float r[8];
#pragma unroll
                for (int i = 0; i < 4; ++i) { r[i] = g0[i] * sigm(g0[i]) * u0[i]; r[4 + i] = g1[i] * sigm(g1[i]) * u1[i]; }
                u32x4 w; w.x = cvt_pk_bf16(r[0], r[1]); w.y = cvt_pk_bf16(r[2], r[3]); w.z = cvt_pk_bf16(r[4], r[5]); w.w = cvt_pk_bf16(r[6], r[7]);
                *(u32x4*)(O + (size_t)(row0 + ai * HALF + m * 16) * ldo + col0) = w; }
    }
};
struct EpiStoreF32 {
    static constexpr bool PERM = false, AFTER_DRAIN = false;
    float* O; int nper;
    __device__ __forceinline__ void operator()(const f32x4 (&acc)[2][2][4][2], const Unit& u, int wr, int wc, int fr, int fq) const {
        const int pnl = u.pn % nper; const int row0 = u.pm * BM + wr * 64 + fr, col0 = pnl * BM + wc * 32 + 4 * fq;
#pragma unroll
        for (int ai = 0; ai < 2; ++ai)
#pragma unroll
            for (int m = 0; m < 4; ++m) { const size_t ro = (size_t)(row0 + ai * HALF + m * 16) * 1024 + col0;
#pragma unroll
                for (int bj = 0; bj < 2; ++bj)
#pragma unroll
                    for (int n = 0; n < 2; ++n) *(f32x4*)(O + ro + bj * HALF + n * 16) = acc[ai][bj][m][n]; }
    }
};
__device__ __forceinline__ void map_unit(int L, int nM, int nN, Unit& u) {
    const int nwg = nM * nN; int wgid = L; { const int q = nwg / NXCD, r = nwg % NXCD, xcd = wgid % NXCD, off = wgid / NXCD; wgid = (xcd < r ? xcd * (q + 1) : r * (q + 1) + (xcd - r) * q) + off; }
    const int nig = WGM * nN, gid = wgid / nig, fm = gid * WGM, gsz = (nM - fm) < WGM ? (nM - fm) : WGM;
    u.pm = fm + ((wgid % nig) % gsz); u.pn = (wgid % nig) / gsz;
}
__device__ __forceinline__ int main_units(int nwg, int G) { const int full = (nwg / G) * G, r = nwg - full; return (r > 0 && r <= G / 8 && full > 0) ? full : nwg; }
constexpr int TAIL_KS = 7, TAIL_K = 512;
typedef int i32x4 __attribute__((ext_vector_type(4)));
struct TableOrder {
    const i32x4* t; int n, G, c;
    __device__ bool next(int i, Unit& u) const { const int j = i * G + c; if (j >= n) return false; const i32x4 e = t[j]; u.pm = e.x; u.pn = e.y; u.koff = e.z; u.aux = e.w; return true; }
    __device__ __forceinline__ void a_ready(const Unit&) const {}
    __device__ __forceinline__ void done(const Unit&) const {}
};
struct EpiStoreTail {
    static constexpr bool PERM = false, AFTER_DRAIN = false;
    float* part;
    __device__ __forceinline__ void operator()(const f32x4 (&acc)[2][2][4][2], const Unit& u, int wr, int wc, int fr, int fq) const {
        float* base = part + (size_t)u.aux * 65536;
        int row0 = wr * 64 + fr, col0 = wc * 32 + 4 * fq; asm volatile("" : "+v"(row0), "+v"(col0));
#pragma unroll
        for (int ai = 0; ai < 2; ++ai)
#pragma unroll
            for (int m = 0; m < 4; ++m) { const size_t ro = (size_t)(row0 + ai * HALF + m * 16) * 256 + col0;
#pragma unroll
                for (int bj = 0; bj < 2; ++bj)
#pragma unroll
                    for (int n = 0; n < 2; ++n) *(f32x4*)(base + ro + bj * HALF + n * 16) = acc[ai][bj][m][n]; }
    }
};
struct MergeOrder {
    StaticOrder b;
    __device__ bool next(int i, Unit& u) const { if (!b.next(i >> 1, u)) return false; if (i & 1) { u.pm += 64; u.pn += 4; } return true; }
    __device__ __forceinline__ void a_ready(const Unit&) const {}
    __device__ __forceinline__ void done(const Unit&) const {}
};
struct MoeOrder {
    StaticOrder b; const int* te; int nper;
    __device__ bool next(int i, Unit& u) const { if (!b.next(i, u)) return false; u.pn += te[u.pm] * nper; return true; }
    __device__ __forceinline__ void a_ready(const Unit&) const {}
    __device__ __forceinline__ void done(const Unit&) const {}
};

template <class Epi, class Sched, bool ALIGN_EPI = false, bool SP2 = false>
__device__ __forceinline__ void gemm_phase(PG8_LAS unsigned char* lds, const Gemm g, const Sched& S, const Epi& E) {
    int tid = threadIdx.x; asm volatile("" : "+v"(tid)); const int wid = __builtin_amdgcn_readfirstlane(tid >> 6), lane = tid & 63, wr = wid >> 2, wc = wid & 3, fr = lane & 15, fq = lane >> 4;
    const int K = g.K, nt = K / BK, LD = g.ld ? g.ld : g.K;
    unsigned voffA[2], voffB[2];
#pragma unroll
    for (int i = 0; i < 2; ++i) { int R, C; stage_rc(tid * 16 + i * 8192, R, C); const int Rb = Epi::PERM ? ((R & ~31) + perm32(R & 31)) : R;
        voffA[i] = (unsigned)(R * LD + C) * 2u; voffB[i] = (unsigned)(Rb * LD + C) * 2u; }
    const unsigned kstep = (unsigned)(BK * 2);
    const unsigned hstep = (unsigned)HALF * LD * 2;
    const unsigned tstep = 2 * hstep;
    const unsigned ldsw = (unsigned)wid * 1024u;
    const int aoff = lds_byte(wr * 64 + fr, fq * 8), boff = lds_byte(wc * 32 + fr, fq * 8);
#define PG8_SA(b, h) (((b) * 2 + (h)) * HTB)
#define PG8_SB(b, h) ((4 + (b) * 2 + (h)) * HTB)
    const __amdgpu_buffer_rsrc_t rs_voffA = __builtin_amdgcn_make_buffer_rsrc((void*)g.A, 0, 0x7fffffff, 0x00020000);
    const __amdgpu_buffer_rsrc_t rs_voffB = __builtin_amdgcn_make_buffer_rsrc((void*)g.Bt, 0, 0x7fffffff, 0x00020000);
#define PG8_STAGE(bufoff, gbase, voff) do { _Pragma("unroll") for (int _i = 0; _i < 2; ++_i) \
        __builtin_amdgcn_raw_ptr_buffer_load_lds(rs_##voff, (PG8_LAS unsigned*)(lds + (bufoff) + ldsw + _i * 8192), 16, (int)(voff)[_i], (int)(gbase), 0, 0); } while (0)
#define PG8_LDA(dst, b, h) do { _Pragma("unroll") for (int m = 0; m < 4; ++m) _Pragma("unroll") for (int k = 0; k < 2; ++k) dst[m][k] = *(const PG8_LAS bf16x8*)(lds + PG8_SA(b, h) + aoff + m * 2048 + k * 1024); } while (0)
#define PG8_LDB(dst, b, h) do { _Pragma("unroll") for (int n = 0; n < 2; ++n) _Pragma("unroll") for (int k = 0; k < 2; ++k) dst[n][k] = *(const PG8_LAS bf16x8*)(lds + PG8_SB(b, h) + boff + n * 2048 + k * 1024); } while (0)
#define PG8_MMA(ai, bj, At, Bt) do { __builtin_amdgcn_s_setprio(1); _Pragma("unroll") for (int m = 0; m < 4; ++m) _Pragma("unroll") for (int n = 0; n < 2; ++n) _Pragma("unroll") for (int k = 0; k < 2; ++k) \
        acc[ai][bj][m][n] = __builtin_amdgcn_mfma_f32_16x16x32_bf16(Bt[n][k], At[m][k], acc[ai][bj][m][n], 0, 0, 0); __builtin_amdgcn_s_setprio(0); } while (0)
#define PG8_WAIT_V(n) asm volatile("s_waitcnt vmcnt(" #n ")" ::: "memory")
#define PG8_WAIT_L(n) asm volatile("s_waitcnt lgkmcnt(" #n ")" ::: "memory")
#define PG8_BAR __builtin_amdgcn_s_barrier()
#define PG8_SCHED __builtin_amdgcn_sched_barrier(0)
    Unit cur, nxt; int ui = 0;
    if (!S.next(0, cur)) return;
    f32x4 acc[2][2][4][2];
#pragma unroll
    for (int a = 0; a < 2; ++a)
#pragma unroll
        for (int b = 0; b < 2; ++b)
#pragma unroll
            for (int m = 0; m < 4; ++m)
#pragma unroll
                for (int n = 0; n < 2; ++n) acc[a][b][m][n] = (f32x4){0.f, 0.f, 0.f, 0.f};
    bf16x8 At[4][2], B0[2][2], B1[2][2];
    unsigned cA = (unsigned)cur.pm * tstep + (unsigned)cur.koff * 2u, cB = (unsigned)cur.pn * tstep + (unsigned)cur.koff * 2u;
    S.a_ready(cur);
    if constexpr (SP2) {
        PG8_STAGE(PG8_SB(0, 0), cB, voffB); PG8_STAGE(PG8_SB(0, 1), cB + hstep, voffB); PG8_STAGE(PG8_SA(0, 0), cA, voffA); PG8_STAGE(PG8_SA(0, 1), cA + hstep, voffA);
        if (wr == 1) PG8_BAR;
        PG8_WAIT_V(2); PG8_BAR;
        PG8_STAGE(PG8_SB(1, 0), cB + kstep, voffB); PG8_STAGE(PG8_SA(1, 0), cA + kstep, voffA); PG8_STAGE(PG8_SB(1, 1), cB + hstep + kstep, voffB);
        PG8_WAIT_V(6); PG8_BAR;
    } else {
        PG8_STAGE(PG8_SB(0, 0), cB, voffB); PG8_STAGE(PG8_SA(0, 0), cA, voffA); PG8_STAGE(PG8_SB(0, 1), cB + hstep, voffB); PG8_STAGE(PG8_SA(0, 1), cA + hstep, voffA);
        if (wr == 1) PG8_BAR;
        PG8_WAIT_V(4); PG8_BAR;
        PG8_STAGE(PG8_SB(1, 0), cB + kstep, voffB); PG8_STAGE(PG8_SA(1, 0), cA + kstep, voffA); PG8_STAGE(PG8_SB(1, 1), cB + hstep + kstep, voffB);
        PG8_WAIT_V(6); PG8_BAR;
    }
    for (;;) {
        const bool has_next = S.next(ui + 1, nxt);
        const unsigned nA = has_next ? (unsigned)nxt.pm * tstep + (unsigned)nxt.koff * 2u : cA, nB = has_next ? (unsigned)nxt.pn * tstep + (unsigned)nxt.koff * 2u : cB;
        for (int t = 0; t < nt; t += 2) {
            const bool last = (t == nt - 2);
            const unsigned a1 = cA + (unsigned)(t + 1) * kstep;
            const unsigned a2 = last ? nA : cA + (unsigned)(t + 2) * kstep, b2 = last ? nB : cB + (unsigned)(t + 2) * kstep;
            const unsigned a3 = a2 + kstep, b3 = b2 + kstep;
            if (last && has_next) S.a_ready(nxt);
            if constexpr (SP2) {
            PG8_LDB(B0, 0, 0); PG8_LDB(B1, 0, 1); PG8_SCHED; PG8_LDA(At, 0, 0); PG8_STAGE(PG8_SA(1, 1), a1 + hstep, voffA);
            PG8_WAIT_V(8); PG8_WAIT_L(0); PG8_BAR; PG8_MMA(0, 0, At, B0); PG8_MMA(0, 1, At, B1); PG8_BAR; PG8_SCHED;
            PG8_LDA(At, 0, 1); PG8_STAGE(PG8_SB(0, 0), b2, voffB); PG8_STAGE(PG8_SB(0, 1), b2 + hstep, voffB); PG8_STAGE(PG8_SA(0, 0), a2, voffA);
            PG8_WAIT_V(8); PG8_WAIT_L(0); PG8_BAR; PG8_MMA(1, 0, At, B0); PG8_MMA(1, 1, At, B1); PG8_BAR; PG8_SCHED;
            PG8_LDB(B0, 1, 0); PG8_LDB(B1, 1, 1); PG8_SCHED; PG8_LDA(At, 1, 0); PG8_STAGE(PG8_SA(0, 1), a2 + hstep, voffA);
            PG8_WAIT_V(8); PG8_WAIT_L(0); PG8_BAR; PG8_MMA(0, 0, At, B0); PG8_MMA(0, 1, At, B1); PG8_BAR; PG8_SCHED;
            PG8_LDA(At, 1, 1); PG8_STAGE(PG8_SB(1, 0), b3, voffB); PG8_STAGE(PG8_SB(1, 1), b3 + hstep, voffB); PG8_STAGE(PG8_SA(1, 0), a3, voffA);
            PG8_WAIT_V(8); PG8_WAIT_L(0); PG8_BAR; PG8_MMA(1, 0, At, B0); PG8_MMA(1, 1, At, B1); PG8_BAR; PG8_SCHED;
            } else {
            PG8_LDB(B0, 0, 0); PG8_SCHED; PG8_LDA(At, 0, 0); PG8_STAGE(PG8_SA(1, 1), a1 + hstep, voffA);
            PG8_WAIT_L(8); PG8_BAR; PG8_WAIT_L(0); PG8_MMA(0, 0, At, B0); PG8_BAR; PG8_SCHED;
            PG8_LDB(B1, 0, 1); PG8_STAGE(PG8_SB(0, 0), b2, voffB);
            PG8_BAR; PG8_WAIT_L(0); PG8_MMA(0, 1, At, B1); PG8_BAR;
            PG8_LDA(At, 0, 1); PG8_STAGE(PG8_SA(0, 0), a2, voffA);
            PG8_BAR; PG8_WAIT_L(0); PG8_MMA(1, 0, At, B0); PG8_BAR; PG8_SCHED;
            PG8_STAGE(PG8_SB(0, 1), b2 + hstep, voffB);
            PG8_WAIT_V(6); PG8_BAR; PG8_MMA(1, 1, At, B1); PG8_BAR;
            PG8_LDB(B0, 1, 0); PG8_SCHED; PG8_LDA(At, 1, 0); PG8_STAGE(PG8_SA(0, 1), a2 + hstep, voffA);
            PG8_WAIT_L(8); PG8_BAR; PG8_WAIT_L(0); PG8_MMA(0, 0, At, B0); PG8_BAR; PG8_SCHED;
            PG8_LDB(B1, 1, 1); PG8_STAGE(PG8_SB(1, 0), b3, voffB);
            PG8_BAR; PG8_WAIT_L(0); PG8_MMA(0, 1, At, B1); PG8_BAR;
            PG8_LDA(At, 1, 1); PG8_STAGE(PG8_SA(1, 0), a3, voffA);
            PG8_BAR; PG8_WAIT_L(0); PG8_MMA(1, 0, At, B0); PG8_BAR; PG8_SCHED;
            PG8_STAGE(PG8_SB(1, 1), b3 + hstep, voffB);
            PG8_WAIT_V(6); PG8_BAR; PG8_MMA(1, 1, At, B1); PG8_BAR;
            }
        }
        if constexpr (ALIGN_EPI) { if (wr == 0) PG8_BAR; }
        if constexpr (!Epi::AFTER_DRAIN) { E(acc, cur, wr, wc, fr, fq); S.done(cur); }
        if (!has_next) break;
#pragma unroll
        for (int a = 0; a < 2; ++a)
#pragma unroll
            for (int b = 0; b < 2; ++b)
#pragma unroll
                for (int m = 0; m < 4; ++m)
#pragma unroll
                    for (int n = 0; n < 2; ++n) acc[a][b][m][n] = (f32x4){0.f, 0.f, 0.f, 0.f};
        cur = nxt; cA = nA; cB = nB; ++ui;
        if constexpr (ALIGN_EPI) { if (wr == 1) PG8_BAR; }
    }
    PG8_WAIT_V(0);
    if constexpr (!ALIGN_EPI) { if (wr == 0) PG8_BAR; }
    PG8_BAR;
    if constexpr (Epi::AFTER_DRAIN) { E.fused(acc, cur, wr, wc, fr, fq, lds, wid, lane); S.done(cur); }
#undef PG8_SA
#undef PG8_SB
#undef PG8_STAGE
#undef PG8_LDA
#undef PG8_LDB
#undef PG8_MMA
#undef PG8_WAIT_V
#undef PG8_WAIT_L
#undef PG8_BAR
#undef PG8_SCHED
}
}
namespace attn_body {
#ifdef NOBIAS
constexpr bool NOBIAS_=true;
#else
constexpr bool NOBIAS_=false;
#endif
using bf16=__hip_bfloat16;
using bf16x8=__attribute__((ext_vector_type(8)))short;
using s16x4=__attribute__((ext_vector_type(4)))short;
using f32x16=__attribute__((ext_vector_type(16)))float;
using u32x4=__attribute__((ext_vector_type(4)))unsigned;
constexpr int SEQ=16384,D=64,PITCH=64,OPITCH=512;
constexpr int NW=8,QBLK=32,QB=QBLK*NW,KVBLK=64,NQB=SEQ/QB;
__device__ __forceinline__ int crow(int r,int hi){return (r&3)+8*(r>>2)+4*hi;}
#define SBAR() __builtin_amdgcn_sched_barrier(0)
__device__ __forceinline__ void cmask(f32x16&p0,f32x16&p1,int jb,int qrel,int hi){
  const float NEG=-INFINITY; int kb=64*jb+4*hi;
  #pragma unroll
  for(int r=0;r<16;++r){int kv=kb+(r&3)+8*(r>>2); if(kv>qrel)p0[r]=NEG; if(kv+32>qrel)p1[r]=NEG;}
}

typedef float f32x4a __attribute__((ext_vector_type(4)));
__device__ __forceinline__ void biasf(f32x16&p0,f32x16&p1,const __attribute__((address_space(3))) float*p){
  #pragma unroll
  for(int j=0;j<4;++j){ const f32x4a a=*(const __attribute__((address_space(3))) f32x4a*)(p+8*j), b=*(const __attribute__((address_space(3))) f32x4a*)(p+32+8*j);
    p0[4*j]+=a[0];p0[4*j+1]+=a[1];p0[4*j+2]+=a[2];p0[4*j+3]+=a[3]; p1[4*j]+=b[0];p1[4*j+1]+=b[1];p1[4*j+2]+=b[2];p1[4*j+3]+=b[3];
    asm volatile("":"+v"(p0),"+v"(p1)); __builtin_amdgcn_sched_barrier(0); }
}
__device__ __forceinline__ void biasd(f32x16&p0,f32x16&p1,const __attribute__((address_space(3))) float*lut,int base){
  #pragma unroll
  for(int r=0;r<16;++r){ const int d0=base-((r&3)+8*(r>>2)); unsigned i0=(unsigned)d0; i0=i0>127u?127u:i0; unsigned i1=(unsigned)(d0-32); i1=i1>127u?127u:i1; p0[r]+=lut[i0]; p1[r]+=lut[i1];
    if((r&3)==3){ asm volatile("":"+v"(p0),"+v"(p1)); __builtin_amdgcn_sched_barrier(0); } }
}
typedef float f32x2a __attribute__((ext_vector_type(2)));
__device__ __forceinline__ void submh(f32x16&p0,f32x16&p1,float mh){ const f32x2a m2={mh,mh};
  #pragma unroll
  for(int r=0;r<16;r+=2){ f32x2a a={p0[r],p0[r+1]}, b={p1[r],p1[r+1]}; a=a-m2; b=b-m2; p0[r]=a[0];p0[r+1]=a[1];p1[r]=b[0];p1[r+1]=b[1]; }
}
constexpr int NSLOT=3, SLOTB=8192;
constexpr int LDS_K=0, LDS_V=NSLOT*SLOTB, LDS_WS=2*NSLOT*SLOTB, LDS_OST=LDS_WS+NW*64*4, LDS_KB=LDS_OST+NW*4096, LDS_CNT=LDS_KB+SEQ*4, LDS_BYTES=LDS_CNT+64;
constexpr float C2=0.125f*1.4426950408889634f;
__device__ __forceinline__ void glds16(const void*gsrc,unsigned lds_dst){unsigned keep;
  asm volatile("s_mov_b32 %0, m0\n\ts_mov_b32 m0, %2\n\ts_nop 0\n\tglobal_load_lds_dwordx4 %1, off\n\ts_mov_b32 m0, %0":"=&s"(keep):"v"(gsrc),"s"(lds_dst):"memory");}
__device__ __forceinline__ float max3f(float a,float b,float c){float r;asm("v_max3_f32 %0, %1, %2, %3":"=v"(r):"v"(a),"v"(b),"v"(c));return r;}
__device__ __forceinline__ float max2f(float a,float b){float r;asm("v_max_f32_e32 %0, %1, %2":"=v"(r):"v"(a),"v"(b));return r;}
__device__ __forceinline__ float fadd_s(float a,float b){float r;asm("v_add_f32_e32 %0, %1, %2":"=v"(r):"v"(a),"v"(b));return r;}
__device__ __forceinline__ float fsub_s(float a,float b){float r;asm("v_sub_f32_e32 %0, %1, %2":"=v"(r):"v"(a),"v"(b));return r;}
typedef float f32x2_t __attribute__((ext_vector_type(2))); typedef __bf16 bf16x2_t __attribute__((ext_vector_type(2)));
__device__ __forceinline__ unsigned cvtpk_s(float lo,float hi){f32x2_t v={lo,hi};bf16x2_t b=__builtin_convertvector(v,bf16x2_t);return __builtin_bit_cast(unsigned,b);}
#define WAIT_BAR(N) asm volatile("s_waitcnt vmcnt(" #N ") lgkmcnt(0)\n\ts_barrier":::"memory")

__device__ __forceinline__ void qkt(f32x16&p0,f32x16&p1,const char*Kslot,const bf16x8*qr,const f32x16&negm,int r32,int hi){
  const char*kb=Kslot+hi*1024+r32*16;
  #pragma unroll
  for(int d0=0;d0<4;++d0){
    const bf16x8 b0=*reinterpret_cast<const bf16x8*>(kb+d0*2048);
    const bf16x8 b1=*reinterpret_cast<const bf16x8*>(kb+d0*2048+512);
    if(d0==0){p0=__builtin_amdgcn_mfma_f32_32x32x16_bf16(b0,qr[0],negm,0,0,0);p1=__builtin_amdgcn_mfma_f32_32x32x16_bf16(b1,qr[0],negm,0,0,0);}
    else{p0=__builtin_amdgcn_mfma_f32_32x32x16_bf16(b0,qr[d0],p0,0,0,0);p1=__builtin_amdgcn_mfma_f32_32x32x16_bf16(b1,qr[d0],p1,0,0,0);}}
}
typedef __attribute__((address_space(3))) const char* lds_cptr;
typedef short v4i16_t __attribute__((ext_vector_type(4)));
__device__ __forceinline__ void kload8(bf16x8*kf,lds_cptr kp){
  kf[0]=*(const __attribute__((address_space(3))) bf16x8*)(kp);      kf[1]=*(const __attribute__((address_space(3))) bf16x8*)(kp+512);
  kf[2]=*(const __attribute__((address_space(3))) bf16x8*)(kp+2048); kf[3]=*(const __attribute__((address_space(3))) bf16x8*)(kp+2560);
  kf[4]=*(const __attribute__((address_space(3))) bf16x8*)(kp+4096); kf[5]=*(const __attribute__((address_space(3))) bf16x8*)(kp+4608);
  kf[6]=*(const __attribute__((address_space(3))) bf16x8*)(kp+6144); kf[7]=*(const __attribute__((address_space(3))) bf16x8*)(kp+6656);
}
__device__ __forceinline__ void kload2(bf16x8*kf,lds_cptr kp,int j){ kf[2*j]=*(const __attribute__((address_space(3))) bf16x8*)(kp+j*2048); kf[2*j+1]=*(const __attribute__((address_space(3))) bf16x8*)(kp+j*2048+512); }
__device__ __forceinline__ s16x4 vtr(lds_cptr p){ return __builtin_bit_cast(s16x4,__builtin_amdgcn_ds_read_tr16_b64_v4i16((__attribute__((address_space(3))) v4i16_t*)p)); }
__device__ __forceinline__ float rowmax(const f32x16&p0,const f32x16&p1){
  float a=max3f(p0[0],p0[1],p1[0]),b=max3f(p0[2],p0[3],p1[1]);a=max3f(a,p1[2],p1[3]);
  #pragma unroll
  for(int r=4;r<16;r+=4){a=max3f(a,p0[r],p0[r+1]);b=max3f(b,p0[r+2],p0[r+3]);a=max3f(a,p1[r],p1[r+1]);b=max3f(b,p1[r+2],p1[r+3]);}
  const float m=max2f(a,b);
  auto rr=__builtin_amdgcn_permlane32_swap(__float_as_uint(m),__float_as_uint(m),false,false);
  return max2f(__uint_as_float(rr[0]),__uint_as_float(rr[1]));
}
__device__ __forceinline__ void pv(f32x16*o,int vb,bf16x8 pa0,bf16x8 pa1,bf16x8 pa2,bf16x8 pa3){
  #pragma unroll
  for(int d0=0;d0<2;++d0){s16x4 lo[4],hi[4];
    #pragma unroll
    for(int ks=0;ks<4;++ks){
      asm volatile("ds_read_b64_tr_b16 %0,%1 offset:%c2":"=&v"(lo[ks]):"v"(vb),"i"(d0*4096+ks*1024):"memory");
      asm volatile("ds_read_b64_tr_b16 %0,%1 offset:%c2":"=&v"(hi[ks]):"v"(vb),"i"(d0*4096+ks*1024+512):"memory");}
    asm volatile("s_waitcnt lgkmcnt(0)":::"memory");SBAR();
    #define PK(k) (bf16x8){lo[k][0],lo[k][1],lo[k][2],lo[k][3],hi[k][0],hi[k][1],hi[k][2],hi[k][3]}
    o[d0]=__builtin_amdgcn_mfma_f32_32x32x16_bf16(pa0,PK(0),o[d0],0,0,0);
    o[d0]=__builtin_amdgcn_mfma_f32_32x32x16_bf16(pa1,PK(1),o[d0],0,0,0);
    o[d0]=__builtin_amdgcn_mfma_f32_32x32x16_bf16(pa2,PK(2),o[d0],0,0,0);
    o[d0]=__builtin_amdgcn_mfma_f32_32x32x16_bf16(pa3,PK(3),o[d0],0,0,0);
    #undef PK
  }
}

#ifndef ATTN_STORE16
#define ATTN_STORE16(p,v) (*(u32x4*)(p)=(v))
#endif
template<int MODE,int THRL> __device__ __forceinline__ void attn_unit(int qb,const bf16*Q,const bf16*__restrict__ K,const bf16*__restrict__ V,bf16*O,const float*__restrict__ cum,const float*__restrict__ relb,const float thr,char*shm){
  int tid=threadIdx.x; asm volatile("":"+v"(tid)); const int lane=tid&63,r32=lane&31,hi=lane>>5; const int wid=__builtin_amdgcn_readfirstlane(tid>>6);
  const int q0=qb*QB;
  const bf16*Qw=Q+(long)(q0+wid*QBLK)*PITCH;
  typedef __attribute__((address_space(3))) float* lds_fptr;
  const lds_fptr kb3=(lds_fptr)(__attribute__((address_space(3))) char*)shm+LDS_KB/4;
  if constexpr(MODE==0){ const float cref=cum[q0]; for(int i=tid;i<q0+QB;i+=NW*64)kb3[i]=(cref-cum[i])*1.4426950408889634f; }
  int tskip=0;
  if constexpr(MODE==0){
    asm volatile("s_waitcnt lgkmcnt(0)\n\ts_barrier":::"memory");
    const int ntf=(q0+QB)/KVBLK; const int c=(tid<ntf)?(kb3[64*tid+63]<=-thr?1:0):0;
    const int cnt=__popcll(__ballot(c));
    const __attribute__((address_space(3))) int* cw=(const __attribute__((address_space(3))) int*)((__attribute__((address_space(3))) char*)shm+LDS_CNT);
    if(lane==0)((__attribute__((address_space(3))) int*)cw)[wid]=cnt;
    asm volatile("s_waitcnt lgkmcnt(0)\n\ts_barrier":::"memory");
    tskip=(cw[0]+cw[1]+cw[2]+cw[3])&~1; tskip=__builtin_amdgcn_readfirstlane(tskip);
  }
  else { if(tid<128){ int bk=tid; if(tid>=16){ bk=16+(int)(__logf((float)tid*(1.f/16.f))/2.0794415416798357f*16.f); bk=bk>31?31:bk; } kb3[tid]=(relb[bk*4]-relb[31*4])*1.4426950408889634f; } }
  const unsigned lds0=(unsigned)(uintptr_t)shm;
  float*wsf=(float*)(shm+LDS_WS)+wid*64;
  const bf16*Kh=K+(long)tskip*KVBLK*PITCH,*Vh=V+(long)tskip*KVBLK*PITCH; const lds_fptr kbt=kb3+64*tskip;
  const bf16*ksrc=Kh+(long)lane*PITCH+wid*8;
  const bf16*vsrc=Vh+(long)(16*(wid&3)+(lane>>2))*PITCH+(wid>>2)*32+(lane&3)*8;
  const unsigned kdst=lds0+LDS_K+wid*1024, vdst=lds0+LDS_V+wid*1024;
  #define DMA_K(t,slot) glds16(ksrc+(long)(t)*KVBLK*PITCH,(unsigned)__builtin_amdgcn_readfirstlane(kdst+(slot)))
  #define DMA_V(t,slot) glds16(vsrc+(long)(t)*KVBLK*PITCH,(unsigned)__builtin_amdgcn_readfirstlane(vdst+(slot)))
  const int vb0=(int)(lds0+LDS_V)+((lane>>4)&1)*32+(lane&3)*8+(4*hi+((lane&15)>>2))*64;
  const char*Kbase=shm+LDS_K; bf16x8 kf[8];
  const lds_cptr shm3=(lds_cptr)shm; const lds_cptr kp0=shm3+LDS_K+hi*1024+r32*16; const lds_cptr vp0=shm3+LDS_V+((lane>>4)&1)*32+(lane&3)*8+(4*hi+((lane&15)>>2))*64;
  const int NT=(q0+QB)/KVBLK-tskip;
  DMA_K(0,0);DMA_V(0,0);DMA_K(1,SLOTB);
  bf16x8 qr[4];
  #pragma unroll
  for(int d0=0;d0<4;++d0)qr[d0]=*reinterpret_cast<const bf16x8*>(&Qw[(long)r32*PITCH+d0*16+hi*8]);
  float mhat=0.f,l_reg=0.f;f32x16 o[2];o[0]=f32x16{};o[1]=f32x16{};const f32x16 z16=f32x16{};
  const int qrel=wid*QBLK+r32;
  #define CMASK(P0,P1,t) do{int jb_=(t)-(NT-4); if(jb_>=0)cmask(P0,P1,jb_,qrel,hi);}while(0)
  #define BIAS(P0,P1,t) do{ if constexpr(NOBIAS_) {} else if constexpr(MODE==0){ biasf(P0,P1,kbt+(64*(t)+4*hi)); } else { biasd(P0,P1,kb3,qrel-64*((t)-(NT-4))-4*hi); } }while(0)
  bool resc=false;
  #define START(P0,P1) do{ const float rm=rowmax(P0,P1); resc=false; \
    { const float dl=rm; mhat=fadd_s(mhat,dl); \
      _Pragma("unroll") for(int r=0;r<16;++r){P0[r]=fsub_s(P0[r],dl);P1[r]=fsub_s(P1[r],dl);} \
      } \
    _Pragma("unroll") for(int r=0;r<16;++r)P0[r]=__builtin_amdgcn_exp2f(P0[r]); }while(0)
  #define RESC() do{ if(resc){ asm volatile("s_waitcnt lgkmcnt(0)":::"memory"); \
      _Pragma("unroll") for(int d_=0;d_<2;++d_) _Pragma("unroll") for(int r=0;r<16;++r)o[d_][r]*=wsf[crow(r,hi)]; } }while(0)
  f32x16 pA0,pA1,pB0,pB1;
  int sl_prev=0,sl_cur=0,sl_next=SLOTB;
  #define ROT() do{sl_prev=sl_cur;sl_cur=sl_next;sl_next=(sl_next==(NSLOT-1)*SLOTB)?0:sl_next+SLOTB;}while(0)
  DMA_K(2,2*SLOTB);
  WAIT_BAR(3);
  qkt(pA0,pA1,Kbase,qr,z16,r32,hi);asm volatile("s_nop 15\n\ts_nop 7":"+v"(pA0),"+v"(pA1));BIAS(pA0,pA1,0);CMASK(pA0,pA1,0);
  START(pA0,pA1);
  _Pragma("unroll") for(int r=0;r<16;++r)pA1[r]=__builtin_amdgcn_exp2f(pA1[r]);
  WAIT_BAR(0);
  DMA_K(3,0);DMA_V(1,SLOTB);
  ROT();
  kload8(kf,kp0+sl_cur);
  WAIT_BAR(2);
  s16x4 vlo[8],vhi[8]; u32x4 pw0,pw1,pw2,pw3;
  #define PKW(P,B) cvtpk_s(P[B],P[B+1])
  #define PAF(k) __builtin_bit_cast(bf16x8,pw##k)
  #define VFR(i) (bf16x8){vlo[i][0],vlo[i][1],vlo[i][2],vlo[i][3],vhi[i][0],vhi[i][1],vhi[i][2],vhi[i][3]}
  #define PIN(x) asm volatile("":"+v"(x))
  #define MX3(a,b,c) __builtin_fmaxf(__builtin_fmaxf((a),(b)),(c))
  #define GAPA(MF,A0,A1,A2,A3,W0,W1,PW) do{ MF; sacc+=A0; sacc+=A1; sacc+=A2; sacc+=A3; PIN(sacc); W0; W1; PIN(PW); SBAR(); }while(0)
  #define EX(v) __builtin_amdgcn_exp2f(v)
  #define GAPB(MF,X,B) do{ MF; X[B]=EX(X[B]); X[B+1]=EX(X[B+1]); X[B+2]=EX(X[B+2]); X[B+3]=EX(X[B+3]); PIN(X); SBAR(); }while(0)
  #define VRD(i) do{ vlo[i]=vtr(vp_+(((i)>>2)*4096+((i)&3)*1024)); vhi[i]=vtr(vp_+(((i)>>2)*4096+((i)&3)*1024+512)); }while(0)
  #define KRD(G,j) do{ if(G){ kload2(kf,kp0+sl_next,j); SBAR(); } }while(0)
  #define STEP(C0,C1,P0,P1,t,GK,GV,GL) do{ SBAR(); \
    const lds_cptr vp_=vp0+sl_prev; \
    VRD(0); SBAR(); float sacc=(P0[0]+P0[1]); \
    GAPA(C0=__builtin_amdgcn_mfma_f32_32x32x16_bf16(kf[0],qr[0],z16,0,0,0), P0[2],P0[3],P0[4],P0[5],     pw0[0]=PKW(P0,0), pw0[1]=PKW(P0,2), pw0); \
    VRD(4); SBAR(); GAPA(C1=__builtin_amdgcn_mfma_f32_32x32x16_bf16(kf[1],qr[0],z16,0,0,0), P0[6],P0[7],P0[8],P0[9],     pw0[2]=PKW(P0,4), pw0[3]=PKW(P0,6), pw0); \
    VRD(1); SBAR(); GAPA(C0=__builtin_amdgcn_mfma_f32_32x32x16_bf16(kf[2],qr[1],C0,0,0,0),   P0[10],P0[11],P0[12],P0[13], pw1[0]=PKW(P0,8), pw1[1]=PKW(P0,10), pw1); \
    VRD(5); SBAR(); GAPA(C1=__builtin_amdgcn_mfma_f32_32x32x16_bf16(kf[3],qr[1],C1,0,0,0),   P0[14],P0[15],P1[0],P1[1],   pw1[2]=PKW(P0,12),pw1[3]=PKW(P0,14), pw1); \
    VRD(2); SBAR(); GAPA(C0=__builtin_amdgcn_mfma_f32_32x32x16_bf16(kf[4],qr[2],C0,0,0,0),   P1[2],P1[3],P1[4],P1[5],     pw2[0]=PKW(P1,0), pw2[1]=PKW(P1,2), pw2); \
    VRD(6); SBAR(); GAPA(C1=__builtin_amdgcn_mfma_f32_32x32x16_bf16(kf[5],qr[2],C1,0,0,0),   P1[6],P1[7],P1[8],P1[9],     pw2[2]=PKW(P1,4), pw2[3]=PKW(P1,6), pw2); \
    VRD(3); SBAR(); GAPA(C0=__builtin_amdgcn_mfma_f32_32x32x16_bf16(kf[6],qr[3],C0,0,0,0),   P1[10],P1[11],P1[12],P1[13], pw3[0]=PKW(P1,8), pw3[1]=PKW(P1,10), pw3); \
    VRD(7); SBAR(); GAPA(C1=__builtin_amdgcn_mfma_f32_32x32x16_bf16(kf[7],qr[3],C1,0,0,0),   P1[14],P1[15],0.f,0.f,       pw3[2]=PKW(P1,12),pw3[3]=PKW(P1,14), pw3); \
    l_reg+=sacc; \
    if(GK){DMA_K((t)+3,sl_cur);} if(GV){DMA_V((t)+1,sl_next);} \
    BIAS(C0,C1,t); CMASK(C0,C1,t); submh(C0,C1,mhat); \
    { float a=MX3(C0[0],C0[1],C1[0]),b=MX3(C0[2],C0[3],C1[1]); a=MX3(a,C1[2],C1[3]); \
      _Pragma("unroll") for(int r=4;r<16;r+=4){a=MX3(a,C0[r],C0[r+1]);b=MX3(b,C0[r+2],C0[r+3]);a=MX3(a,C1[r],C1[r+1]);b=MX3(b,C1[r+2],C1[r+3]);} \
      float rm=__builtin_fmaxf(a,b); { auto rr=__builtin_amdgcn_permlane32_swap(__float_as_uint(rm),__float_as_uint(rm),false,false); rm=__builtin_fmaxf(__uint_as_float(rr[0]),__uint_as_float(rr[1])); } \
      resc=false; \
      if(__builtin_expect(__any(rm>(float)THRL),0)){ const float dl=__builtin_fmaxf(rm,0.f); mhat+=dl; \
        _Pragma("unroll") for(int r=0;r<16;++r){C0[r]-=dl;C1[r]-=dl;} \
        const float f=__builtin_amdgcn_exp2f(-dl); l_reg*=f; if(hi==0)wsf[r32]=f; resc=true; } } \
    SBAR(); \
    GAPB(o[0]=__builtin_amdgcn_mfma_f32_32x32x16_bf16(PAF(0),VFR(0),o[0],0,0,0), C0,0); \
    GAPB(o[1]=__builtin_amdgcn_mfma_f32_32x32x16_bf16(PAF(0),VFR(4),o[1],0,0,0), C0,4); \
    KRD(GL,0); GAPB(o[0]=__builtin_amdgcn_mfma_f32_32x32x16_bf16(PAF(1),VFR(1),o[0],0,0,0), C0,8); \
    KRD(GL,1); GAPB(o[1]=__builtin_amdgcn_mfma_f32_32x32x16_bf16(PAF(1),VFR(5),o[1],0,0,0), C0,12); \
    KRD(GL,2); GAPB(o[0]=__builtin_amdgcn_mfma_f32_32x32x16_bf16(PAF(2),VFR(2),o[0],0,0,0), C1,0); \
    KRD(GL,3); GAPB(o[1]=__builtin_amdgcn_mfma_f32_32x32x16_bf16(PAF(2),VFR(6),o[1],0,0,0), C1,4); \
    GAPB(o[0]=__builtin_amdgcn_mfma_f32_32x32x16_bf16(PAF(3),VFR(3),o[0],0,0,0), C1,8); \
    GAPB(o[1]=__builtin_amdgcn_mfma_f32_32x32x16_bf16(PAF(3),VFR(7),o[1],0,0,0), C1,12); \
    }while(0)
  int t=1;
  #undef CMASK
  #define CMASK(P0,P1,t) do{}while(0)
  #undef BIAS
  #define BIAS(P0,P1,t) do{ if constexpr(NOBIAS_) {} else if constexpr(MODE==0){ biasf(P0,P1,kbt+(64*(t)+4*hi)); } }while(0)
  constexpr int NEAR=(MODE==1)?7:5;
  for(;t+NEAR<NT;t+=2){
    STEP(pB0,pB1,pA0,pA1,t,true,true,true);     WAIT_BAR(2); RESC(); ROT();
    STEP(pA0,pA1,pB0,pB1,t+1,true,true,true);   WAIT_BAR(2); RESC(); ROT();
  }
  #undef CMASK
  #define CMASK(P0,P1,t) do{int jb_=(t)-(NT-4); if(jb_>=0)cmask(P0,P1,jb_,qrel,hi);}while(0)
  #undef BIAS
  #define BIAS(P0,P1,t) do{ if constexpr(NOBIAS_) {} else if constexpr(MODE==0){ biasf(P0,P1,kbt+(64*(t)+4*hi)); } else { biasd(P0,P1,kb3,qrel-64*((t)-(NT-4))-4*hi); } }while(0)
  #define ENDW(tt) do{ if((tt)+3<NT){WAIT_BAR(2);} else if((tt)+2<NT){WAIT_BAR(1);} else {WAIT_BAR(0);} }while(0)
  for(;t+1<NT;t+=2){
    STEP(pB0,pB1,pA0,pA1,t,(t+3<NT),(t+1<NT),(t+1<NT));       ENDW(t);   RESC(); ROT();
    STEP(pA0,pA1,pB0,pB1,t+1,(t+4<NT),(t+2<NT),(t+2<NT));     ENDW(t+1); RESC(); ROT();
  }
  STEP(pB0,pB1,pA0,pA1,NT-1,false,false,false); RESC();
  { float sacc=pB0[0]+pB0[1]; _Pragma("unroll") for(int r=2;r<16;++r)sacc+=pB0[r]; _Pragma("unroll") for(int r=0;r<16;++r)sacc+=pB1[r]; l_reg+=sacc;
    pw0=(u32x4){PKW(pB0,0),PKW(pB0,2),PKW(pB0,4),PKW(pB0,6)};pw1=(u32x4){PKW(pB0,8),PKW(pB0,10),PKW(pB0,12),PKW(pB0,14)};pw2=(u32x4){PKW(pB1,0),PKW(pB1,2),PKW(pB1,4),PKW(pB1,6)};pw3=(u32x4){PKW(pB1,8),PKW(pB1,10),PKW(pB1,12),PKW(pB1,14)};
    SBAR(); pv(o,vb0+sl_cur,PAF(0),PAF(1),PAF(2),PAF(3)); }
  #undef PKW
  #undef PAF
  #undef VFR
  #undef PIN
  #undef MX3
  #undef GAPA
  #undef GAPB
  #undef EX
  #undef VRD
  #undef KRD
  #undef STEP
  #undef ENDW
  {auto rr=__builtin_amdgcn_permlane32_swap(__float_as_uint(l_reg),__float_as_uint(l_reg),false,false);l_reg=__uint_as_float(rr[0])+__uint_as_float(rr[1]);}
  if(hi==0)wsf[32+r32]=l_reg;asm volatile("s_waitcnt lgkmcnt(0)":::"memory");
  float rli[16];
  #pragma unroll
  for(int r=0;r<16;++r)rli[r]=__builtin_amdgcn_rcpf(wsf[32+crow(r,hi)]);
  bf16*Ow=O+(long)(q0+wid*QBLK)*OPITCH;
  { bf16*stg=(bf16*)(shm+LDS_OST)+wid*2048;
    #pragma unroll
    for(int r=0;r<16;++r){const int orow=crow(r,hi);
      #pragma unroll
      for(int d0=0;d0<2;++d0)stg[orow*64+d0*32+r32]=__float2bfloat16(o[d0][r]*rli[r]);}
    asm volatile("s_waitcnt lgkmcnt(0)":::"memory");
    #pragma unroll
    for(int i=0;i<4;++i){const int row=i*8+(lane>>3),ch=lane&7; const u32x4 v=*(const u32x4*)(stg+row*64+ch*8); ATTN_STORE16(Ow+(long)row*OPITCH+ch*8,v);} }
  asm volatile("s_waitcnt lgkmcnt(0)\n\ts_barrier":::"memory");
  #undef DMA_K
  #undef DMA_V
  #undef CMASK
  #undef BIAS
  #undef START
  #undef RESC
  #undef ROT
}
template<int THRL> __device__ __forceinline__ void attn_unit_d(int qb,const bf16*Q,const bf16*__restrict__ K,const bf16*__restrict__ V,bf16*O,const float*__restrict__ cum,const float*__restrict__ relb,const float thr,char*shm){
  int tid=threadIdx.x; asm volatile("":"+v"(tid)); const int lane=tid&63,r32=lane&31,hi=lane>>5; const int wid=__builtin_amdgcn_readfirstlane(tid>>6);
  constexpr int MODE=1; constexpr int VSLOT=16384; constexpr int LDS_WS=LDS_V+NSLOT*VSLOT, LDS_OST=LDS_WS+NW*64*4, LDS_KB=LDS_OST+NW*4096; static_assert(LDS_KB+512<=LDS_BYTES,"lds");
  const int q0=qb*QB;
  const bf16*Qw=Q+(long)(q0+wid*QBLK)*PITCH;
  typedef __attribute__((address_space(3))) float* lds_fptr;
  const lds_fptr kb3=(lds_fptr)(__attribute__((address_space(3))) char*)shm+LDS_KB/4;
  if constexpr(MODE==0){ const float cref=cum[q0]; for(int i=tid;i<q0+QB;i+=NW*64)kb3[i]=(cref-cum[i])*1.4426950408889634f; }
  int tskip=0;
  if constexpr(MODE==0){
    asm volatile("s_waitcnt lgkmcnt(0)\n\ts_barrier":::"memory");
    const int ntf=(q0+QB)/KVBLK; const int c=(tid<ntf)?(kb3[64*tid+63]<=-thr?1:0):0;
    const int cnt=__popcll(__ballot(c));
    const __attribute__((address_space(3))) int* cw=(const __attribute__((address_space(3))) int*)((__attribute__((address_space(3))) char*)shm+LDS_CNT);
    if(lane==0)((__attribute__((address_space(3))) int*)cw)[wid]=cnt;
    asm volatile("s_waitcnt lgkmcnt(0)\n\ts_barrier":::"memory");
    tskip=(cw[0]+cw[1]+cw[2]+cw[3])&~1; tskip=__builtin_amdgcn_readfirstlane(tskip);
  }
  else { if(tid<128){ int bk=tid; if(tid>=16){ bk=16+(int)(__logf((float)tid*(1.f/16.f))/2.0794415416798357f*16.f); bk=bk>31?31:bk; } kb3[tid]=(relb[bk*4]-relb[31*4])*1.4426950408889634f; } }
  const unsigned lds0=(unsigned)(uintptr_t)shm;
  float*wsf=(float*)(shm+LDS_WS)+wid*64;
  const bf16*Kh=K+(long)tskip*KVBLK*PITCH,*Vh=V+(long)tskip*KVBLK*PITCH; const lds_fptr kbt=kb3+64*tskip;
  const bf16*ksrc=Kh+(long)lane*PITCH+wid*8;
  constexpr int VPITCH=128;
  const bf16*vsrc=Vh+(long)(16*(wid&3)+(lane>>2))*VPITCH+(wid>>2)*32+(lane&3)*8;
  const unsigned kdst=lds0+LDS_K+wid*1024, vdst=lds0+LDS_V+wid*1024;
  #define DMA_K(t,slot) glds16(ksrc+(long)(t)*KVBLK*PITCH,(unsigned)__builtin_amdgcn_readfirstlane(kdst+(slot)))
  #define DMA_V(t,slot) do{ glds16(vsrc+(long)(t)*KVBLK*VPITCH,(unsigned)__builtin_amdgcn_readfirstlane(vdst+(slot))); glds16(vsrc+64+(long)(t)*KVBLK*VPITCH,(unsigned)__builtin_amdgcn_readfirstlane(vdst+8192+(slot))); }while(0)
  const int vb0=(int)(lds0+LDS_V)+((lane>>4)&1)*32+(lane&3)*8+(4*hi+((lane&15)>>2))*64;
  const char*Kbase=shm+LDS_K; bf16x8 kf[8];
  const lds_cptr shm3=(lds_cptr)shm; const lds_cptr kp0=shm3+LDS_K+hi*1024+r32*16; const lds_cptr vp0=shm3+LDS_V+((lane>>4)&1)*32+(lane&3)*8+(4*hi+((lane&15)>>2))*64;
  const int NT=(q0+QB)/KVBLK-tskip;
  DMA_K(0,0);DMA_V(0,0);DMA_K(1,SLOTB);
  bf16x8 qr[4];
  #pragma unroll
  for(int d0=0;d0<4;++d0)qr[d0]=*reinterpret_cast<const bf16x8*>(&Qw[(long)r32*PITCH+d0*16+hi*8]);
  float mhat=0.f,l_reg=0.f;f32x16 o[4];o[0]=f32x16{};o[1]=f32x16{};o[2]=f32x16{};o[3]=f32x16{};const f32x16 z16=f32x16{};
  const int qrel=wid*QBLK+r32;
  #define CMASK(P0,P1,t) do{int jb_=(t)-(NT-4); if(jb_>=0)cmask(P0,P1,jb_,qrel,hi);}while(0)
  #define BIAS(P0,P1,t) do{ if constexpr(NOBIAS_) {} else if constexpr(MODE==0){ biasf(P0,P1,kbt+(64*(t)+4*hi)); } else { biasd(P0,P1,kb3,qrel-64*((t)-(NT-4))-4*hi); } }while(0)
  bool resc=false;
  #define START(P0,P1) do{ const float rm=rowmax(P0,P1); resc=false; \
    { const float dl=rm; mhat=fadd_s(mhat,dl); \
      _Pragma("unroll") for(int r=0;r<16;++r){P0[r]=fsub_s(P0[r],dl);P1[r]=fsub_s(P1[r],dl);} \
      } \
    _Pragma("unroll") for(int r=0;r<16;++r)P0[r]=__builtin_amdgcn_exp2f(P0[r]); }while(0)
  #define RESC() do{ if(resc){ asm volatile("s_waitcnt lgkmcnt(0)":::"memory"); \
      _Pragma("unroll") for(int d_=0;d_<4;++d_) _Pragma("unroll") for(int r=0;r<16;++r)o[d_][r]*=wsf[crow(r,hi)]; } }while(0)
  f32x16 pA0,pA1,pB0,pB1;
  int sl_prev=0,sl_cur=0,sl_next=SLOTB;
  #define ROT() do{sl_prev=sl_cur;sl_cur=sl_next;sl_next=(sl_next==(NSLOT-1)*SLOTB)?0:sl_next+SLOTB;}while(0)
  DMA_K(2,2*SLOTB);
  WAIT_BAR(4);
  qkt(pA0,pA1,Kbase,qr,z16,r32,hi);asm volatile("s_nop 15\n\ts_nop 7":"+v"(pA0),"+v"(pA1));BIAS(pA0,pA1,0);CMASK(pA0,pA1,0);
  START(pA0,pA1);
  _Pragma("unroll") for(int r=0;r<16;++r)pA1[r]=__builtin_amdgcn_exp2f(pA1[r]);
  WAIT_BAR(0);
  DMA_K(3,0);DMA_V(1,VSLOT);
  ROT();
  kload8(kf,kp0+sl_cur);
  WAIT_BAR(3);
  s16x4 vlo[8],vhi[8]; u32x4 pw0,pw1,pw2,pw3;
  #define PKW(P,B) cvtpk_s(P[B],P[B+1])
  #define PAF(k) __builtin_bit_cast(bf16x8,pw##k)
  #define VFR(i) (bf16x8){vlo[i][0],vlo[i][1],vlo[i][2],vlo[i][3],vhi[i][0],vhi[i][1],vhi[i][2],vhi[i][3]}
  #define PIN(x) asm volatile("":"+v"(x))
  #define MX3(a,b,c) __builtin_fmaxf(__builtin_fmaxf((a),(b)),(c))
  #define GAPA(MF,A0,A1,A2,A3,W0,W1,PW) do{ MF; sacc+=A0; sacc+=A1; sacc+=A2; sacc+=A3; PIN(sacc); W0; W1; PIN(PW); SBAR(); }while(0)
  #define EX(v) __builtin_amdgcn_exp2f(v)
  #define GAPB(MF,X,B) do{ MF; X[B]=EX(X[B]); X[B+1]=EX(X[B+1]); PIN(X); SBAR(); }while(0)
  #define VRD2(i) do{ vlo[i]=vtr(vp_+(8192+((i)>>2)*4096+((i)&3)*1024)); vhi[i]=vtr(vp_+(8192+((i)>>2)*4096+((i)&3)*1024+512)); }while(0)
  #define VRD(i) do{ vlo[i]=vtr(vp_+(((i)>>2)*4096+((i)&3)*1024)); vhi[i]=vtr(vp_+(((i)>>2)*4096+((i)&3)*1024+512)); }while(0)
  #define KRD(G,j) do{ if(G){ kload2(kf,kp0+sl_next,j); SBAR(); } }while(0)
  #define STEP(C0,C1,P0,P1,t,GK,GV,GL) do{ SBAR(); \
    const lds_cptr vp_=vp0+2*sl_prev; \
    VRD(0); SBAR(); float sacc=(P0[0]+P0[1]); \
    GAPA(C0=__builtin_amdgcn_mfma_f32_32x32x16_bf16(kf[0],qr[0],z16,0,0,0), P0[2],P0[3],P0[4],P0[5],     pw0[0]=PKW(P0,0), pw0[1]=PKW(P0,2), pw0); \
    VRD(4); SBAR(); GAPA(C1=__builtin_amdgcn_mfma_f32_32x32x16_bf16(kf[1],qr[0],z16,0,0,0), P0[6],P0[7],P0[8],P0[9],     pw0[2]=PKW(P0,4), pw0[3]=PKW(P0,6), pw0); \
    VRD(1); SBAR(); GAPA(C0=__builtin_amdgcn_mfma_f32_32x32x16_bf16(kf[2],qr[1],C0,0,0,0),   P0[10],P0[11],P0[12],P0[13], pw1[0]=PKW(P0,8), pw1[1]=PKW(P0,10), pw1); \
    VRD(5); SBAR(); GAPA(C1=__builtin_amdgcn_mfma_f32_32x32x16_bf16(kf[3],qr[1],C1,0,0,0),   P0[14],P0[15],P1[0],P1[1],   pw1[2]=PKW(P0,12),pw1[3]=PKW(P0,14), pw1); \
    VRD(2); SBAR(); GAPA(C0=__builtin_amdgcn_mfma_f32_32x32x16_bf16(kf[4],qr[2],C0,0,0,0),   P1[2],P1[3],P1[4],P1[5],     pw2[0]=PKW(P1,0), pw2[1]=PKW(P1,2), pw2); \
    VRD(6); SBAR(); GAPA(C1=__builtin_amdgcn_mfma_f32_32x32x16_bf16(kf[5],qr[2],C1,0,0,0),   P1[6],P1[7],P1[8],P1[9],     pw2[2]=PKW(P1,4), pw2[3]=PKW(P1,6), pw2); \
    VRD(3); SBAR(); GAPA(C0=__builtin_amdgcn_mfma_f32_32x32x16_bf16(kf[6],qr[3],C0,0,0,0),   P1[10],P1[11],P1[12],P1[13], pw3[0]=PKW(P1,8), pw3[1]=PKW(P1,10), pw3); \
    VRD(7); SBAR(); GAPA(C1=__builtin_amdgcn_mfma_f32_32x32x16_bf16(kf[7],qr[3],C1,0,0,0),   P1[14],P1[15],0.f,0.f,       pw3[2]=PKW(P1,12),pw3[3]=PKW(P1,14), pw3); \
    l_reg+=sacc; \
    if(GK){DMA_K((t)+3,sl_cur);} if(GV){DMA_V((t)+1,2*sl_next);} \
    BIAS(C0,C1,t); CMASK(C0,C1,t); submh(C0,C1,mhat); \
    { float a=MX3(C0[0],C0[1],C1[0]),b=MX3(C0[2],C0[3],C1[1]); a=MX3(a,C1[2],C1[3]); \
      _Pragma("unroll") for(int r=4;r<16;r+=4){a=MX3(a,C0[r],C0[r+1]);b=MX3(b,C0[r+2],C0[r+3]);a=MX3(a,C1[r],C1[r+1]);b=MX3(b,C1[r+2],C1[r+3]);} \
      float rm=__builtin_fmaxf(a,b); { auto rr=__builtin_amdgcn_permlane32_swap(__float_as_uint(rm),__float_as_uint(rm),false,false); rm=__builtin_fmaxf(__uint_as_float(rr[0]),__uint_as_float(rr[1])); } \
      resc=false; \
      if(__builtin_expect(__any(rm>(float)THRL),0)){ const float dl=__builtin_fmaxf(rm,0.f); mhat+=dl; \
        _Pragma("unroll") for(int r=0;r<16;++r){C0[r]-=dl;C1[r]-=dl;} \
        const float f=__builtin_amdgcn_exp2f(-dl); l_reg*=f; if(hi==0)wsf[r32]=f; resc=true; } } \
    SBAR(); \
    GAPB(o[0]=__builtin_amdgcn_mfma_f32_32x32x16_bf16(PAF(0),VFR(0),o[0],0,0,0), C0,0);  VRD2(0); SBAR(); \
    GAPB(o[1]=__builtin_amdgcn_mfma_f32_32x32x16_bf16(PAF(0),VFR(4),o[1],0,0,0), C0,2);  VRD2(4); SBAR(); \
    KRD(GL,0); GAPB(o[0]=__builtin_amdgcn_mfma_f32_32x32x16_bf16(PAF(1),VFR(1),o[0],0,0,0), C0,4);  VRD2(1); SBAR(); \
    KRD(GL,1); GAPB(o[1]=__builtin_amdgcn_mfma_f32_32x32x16_bf16(PAF(1),VFR(5),o[1],0,0,0), C0,6);  VRD2(5); SBAR(); \
    KRD(GL,2); GAPB(o[0]=__builtin_amdgcn_mfma_f32_32x32x16_bf16(PAF(2),VFR(2),o[0],0,0,0), C0,8);  VRD2(2); SBAR(); \
    KRD(GL,3); GAPB(o[1]=__builtin_amdgcn_mfma_f32_32x32x16_bf16(PAF(2),VFR(6),o[1],0,0,0), C0,10); VRD2(6); SBAR(); \
    GAPB(o[0]=__builtin_amdgcn_mfma_f32_32x32x16_bf16(PAF(3),VFR(3),o[0],0,0,0), C0,12); VRD2(3); SBAR(); \
    GAPB(o[1]=__builtin_amdgcn_mfma_f32_32x32x16_bf16(PAF(3),VFR(7),o[1],0,0,0), C0,14); VRD2(7); SBAR(); \
    GAPB(o[2]=__builtin_amdgcn_mfma_f32_32x32x16_bf16(PAF(0),VFR(0),o[2],0,0,0), C1,0); \
    GAPB(o[3]=__builtin_amdgcn_mfma_f32_32x32x16_bf16(PAF(0),VFR(4),o[3],0,0,0), C1,2); \
    GAPB(o[2]=__builtin_amdgcn_mfma_f32_32x32x16_bf16(PAF(1),VFR(1),o[2],0,0,0), C1,4); \
    GAPB(o[3]=__builtin_amdgcn_mfma_f32_32x32x16_bf16(PAF(1),VFR(5),o[3],0,0,0), C1,6); \
    GAPB(o[2]=__builtin_amdgcn_mfma_f32_32x32x16_bf16(PAF(2),VFR(2),o[2],0,0,0), C1,8); \
    GAPB(o[3]=__builtin_amdgcn_mfma_f32_32x32x16_bf16(PAF(2),VFR(6),o[3],0,0,0), C1,10); \
    GAPB(o[2]=__builtin_amdgcn_mfma_f32_32x32x16_bf16(PAF(3),VFR(3),o[2],0,0,0), C1,12); \
    GAPB(o[3]=__builtin_amdgcn_mfma_f32_32x32x16_bf16(PAF(3),VFR(7),o[3],0,0,0), C1,14); \
    }while(0)
  int t=1;
  #undef CMASK
  #define CMASK(P0,P1,t) do{}while(0)
  #undef BIAS
  #define BIAS(P0,P1,t) do{ if constexpr(NOBIAS_) {} else if constexpr(MODE==0){ biasf(P0,P1,kbt+(64*(t)+4*hi)); } }while(0)
  constexpr int NEAR=(MODE==1)?7:5;
  for(;t+NEAR<NT;t+=2){
    STEP(pB0,pB1,pA0,pA1,t,true,true,true);     WAIT_BAR(3); RESC(); ROT();
    STEP(pA0,pA1,pB0,pB1,t+1,true,true,true);   WAIT_BAR(3); RESC(); ROT();
  }
  #undef CMASK
  #define CMASK(P0,P1,t) do{int jb_=(t)-(NT-4); if(jb_>=0)cmask(P0,P1,jb_,qrel,hi);}while(0)
  #undef BIAS
  #define BIAS(P0,P1,t) do{ if constexpr(NOBIAS_) {} else if constexpr(MODE==0){ biasf(P0,P1,kbt+(64*(t)+4*hi)); } else { biasd(P0,P1,kb3,qrel-64*((t)-(NT-4))-4*hi); } }while(0)
  #define ENDW(tt) do{ if((tt)+3<NT){WAIT_BAR(3);} else if((tt)+2<NT){WAIT_BAR(2);} else {WAIT_BAR(0);} }while(0)
  for(;t+1<NT;t+=2){
    STEP(pB0,pB1,pA0,pA1,t,(t+3<NT),(t+1<NT),(t+1<NT));       ENDW(t);   RESC(); ROT();
    STEP(pA0,pA1,pB0,pB1,t+1,(t+4<NT),(t+2<NT),(t+2<NT));     ENDW(t+1); RESC(); ROT();
  }
  STEP(pB0,pB1,pA0,pA1,NT-1,false,false,false); RESC();
  { float sacc=pB0[0]+pB0[1]; _Pragma("unroll") for(int r=2;r<16;++r)sacc+=pB0[r]; _Pragma("unroll") for(int r=0;r<16;++r)sacc+=pB1[r]; l_reg+=sacc;
    pw0=(u32x4){PKW(pB0,0),PKW(pB0,2),PKW(pB0,4),PKW(pB0,6)};pw1=(u32x4){PKW(pB0,8),PKW(pB0,10),PKW(pB0,12),PKW(pB0,14)};pw2=(u32x4){PKW(pB1,0),PKW(pB1,2),PKW(pB1,4),PKW(pB1,6)};pw3=(u32x4){PKW(pB1,8),PKW(pB1,10),PKW(pB1,12),PKW(pB1,14)};
    SBAR(); pv(o,vb0+2*sl_cur,PAF(0),PAF(1),PAF(2),PAF(3)); pv(o+2,vb0+2*sl_cur+8192,PAF(0),PAF(1),PAF(2),PAF(3)); }
  #undef PKW
  #undef PAF
  #undef VFR
  #undef PIN
  #undef MX3
  #undef GAPA
  #undef GAPB
  #undef EX
  #undef VRD
  #undef VRD2
  #undef KRD
  #undef STEP
  #undef ENDW
  {auto rr=__builtin_amdgcn_permlane32_swap(__float_as_uint(l_reg),__float_as_uint(l_reg),false,false);l_reg=__uint_as_float(rr[0])+__uint_as_float(rr[1]);}
  if(hi==0)wsf[32+r32]=l_reg;asm volatile("s_waitcnt lgkmcnt(0)":::"memory");
  float rli[16];
  #pragma unroll
  for(int r=0;r<16;++r)rli[r]=__builtin_amdgcn_rcpf(wsf[32+crow(r,hi)]);
  bf16*Ow=O+(long)(q0+wid*QBLK)*OPITCH;
  { bf16*stg=(bf16*)(shm+LDS_OST)+wid*2048;
    #pragma unroll
    for(int ps=0;ps<2;++ps){
      #pragma unroll
      for(int r=0;r<16;++r){const int orow=crow(r,hi);
        #pragma unroll
        for(int d0=0;d0<2;++d0)stg[orow*64+d0*32+r32]=__float2bfloat16(o[2*ps+d0][r]*rli[r]);}
      asm volatile("s_waitcnt lgkmcnt(0)":::"memory");
      #pragma unroll
      for(int i=0;i<4;++i){const int row=i*8+(lane>>3),ch=lane&7; const u32x4 v=*(const u32x4*)(stg+row*64+ch*8); ATTN_STORE16(Ow+(long)row*OPITCH+ps*64+ch*8,v);}
      asm volatile("s_waitcnt lgkmcnt(0)":::"memory"); } }
  asm volatile("s_waitcnt lgkmcnt(0)\n\ts_barrier":::"memory");
  #undef DMA_K
  #undef DMA_V
  #undef CMASK
  #undef BIAS
  #undef START
  #undef RESC
  #undef ROT
}
constexpr int ATTN_LDS_BYTES=LDS_BYTES;
#undef SBAR
#undef WAIT_BAR
}
#define LAS __attribute__((address_space(3)))
typedef unsigned short bf16;
typedef unsigned v4u __attribute__((ext_vector_type(4)));
typedef unsigned v2u __attribute__((ext_vector_type(2)));
typedef float f32x4 __attribute__((ext_vector_type(4)));
constexpr int NWAVES = 8, NT = 512;
constexpr int M = 16384, DMODEL = 1024, NIN = 5128, NPROJ = 5120, DFF = 2816, DFFE = 3584, NEXP = 8;
constexpr float LN_EPS = 1e-5f, SUBLN_EPS = 1e-5f, ALPHA = 1.4142135623730951f  , LOG2E = 1.4426950408889634f;
constexpr size_t MiB = 1u << 20;
constexpr size_t WS_CTL = 0;
constexpr size_t WS_BAR = 16384;
constexpr size_t WS_LOGF = 1 * MiB, WS_CUM = 2 * MiB, WS_EIDX = 3 * MiB, WS_GW = 3 * MiB + 256 * 1024, WS_POS = 3 * MiB + 512 * 1024, WS_TILEE = 3 * MiB + 768 * 1024;
constexpr size_t WS_STATS = 4 * MiB;
constexpr size_t WS_WIN = 16 * MiB, WS_WBR = 36 * MiB, WS_WO = 40 * MiB, WS_WGU = 44 * MiB, WS_WDN = 55 * MiB, WS_WEGU = 61 * MiB, WS_WEDN = 173 * MiB;
constexpr size_t WS_H = 229 * MiB, WS_HB = 293 * MiB;
constexpr size_t WS_PROJ = 325 * MiB, WS_YATT = 485 * MiB, WS_ODIFF = 517 * MiB, WS_T = 549 * MiB, WS_MERGED = 613 * MiB, WS_Z = 645 * MiB, WS_ACT = 709 * MiB;
constexpr size_t WS_XS = 325 * MiB, WS_ACTS = 393 * MiB, WS_YS = 709 * MiB, WS_END = 845 * MiB;
constexpr int MAXP = 2 * M + NEXP * 256;
static_assert(WS_XS + (size_t)MAXP * 1024 * 2 <= WS_ACTS && WS_ACTS + (size_t)MAXP * DFFE * 2 <= WS_Z && WS_YS + (size_t)MAXP * 1024 * 4 <= WS_END, "moe overlay");
static_assert(WS_PROJ + (size_t)M * NPROJ * 2 <= WS_YATT && WS_ACT + (size_t)M * DFF * 2 <= WS_END, "ws map");
constexpr int LDS_BYTES = attn_body::LDS_BYTES + 1024;
static_assert(attn_body::LDS_BYTES >= pg8::STAGE_BYTES && LDS_BYTES <= 163840, "lds");

__device__ __forceinline__ unsigned f2bf(float f) { unsigned u = __builtin_bit_cast(unsigned, f); return (u + 0x7fffu + ((u >> 16) & 1u)) >> 16; }
__device__ __forceinline__ unsigned pk2(float lo, float hi) { return f2bf(lo) | (f2bf(hi) << 16); }
__device__ __forceinline__ float wave_sum(float v) {
#pragma unroll
    for (int o = 1; o < 64; o <<= 1) v += __shfl_xor(v, o);
    return v;
}
__device__ __forceinline__ void tr_block(const float* src  , int ldw, bf16* dst  , int K, LAS float* scr, int lane) {
    const int kr = lane >> 3, c4 = lane & 7;
    f32x4 v[8];
#pragma unroll
    for (int i = 0; i < 8; ++i) v[i] = *(const f32x4*)(src + (size_t)(8 * i + kr) * ldw + 4 * c4);
#pragma unroll
    for (int i = 0; i < 8; ++i) { LAS float* d = scr + (8 * i + kr) * 33 + 4 * c4; d[0] = v[i].x; d[1] = v[i].y; d[2] = v[i].z; d[3] = v[i].w; }
    asm volatile("s_waitcnt lgkmcnt(0)" ::: "memory");
    const int c = lane & 7;
#pragma unroll
    for (int j = 0; j < 4; ++j) { const int n = (lane >> 3) + 8 * j; const LAS float* s = scr + (8 * c) * 33 + n;
        v4u o; o.x = pk2(s[0 * 33], s[1 * 33]); o.y = pk2(s[2 * 33], s[3 * 33]); o.z = pk2(s[4 * 33], s[5 * 33]); o.w = pk2(s[6 * 33], s[7 * 33]);
        *(v4u*)(dst + (size_t)n * K + 8 * c) = o; }
    asm volatile("s_waitcnt lgkmcnt(0)" ::: "memory");
}
template <int MAP> __device__ __forceinline__ void tr_seg(const float* W, int ldw, int K, int c0, int ncols, bf16* WT, int row_off, int F, LAS float* scr, int item, int lane) {
    const int nblk = ncols / 32, kb = item / nblk, nb = item % nblk, k0 = 64 * kb, n0 = 32 * nb;
    int drow;
    if (MAP == 0) drow = row_off + n0; else { int c = n0; const int up = c >= F; if (up) c -= F; drow = row_off + 256 * (c / 128) + 128 * up + (c % 128); }
    tr_block(W + (size_t)k0 * ldw + c0 + n0, ldw, WT + (size_t)drow * K + k0, K, scr, lane);
}

#define XB_TMO      128
#define XB_XCNT(j)  (256  + 64 * (j))
#define XB_XSUB(j)  (1280 + 64 * (j))
#define XB_XGEN(j)  (2304 + 64 * (j))
#define XB_TOP      3328
#define XB_TOPGEN   3392
#define XCD_BAR_WORDS 3456
#define XB_SPIN_CAP (1u << 18)

__device__ __forceinline__ unsigned xb_ld(unsigned* p)              { return __hip_atomic_load(p, __ATOMIC_RELAXED, __HIP_MEMORY_SCOPE_AGENT); }
__device__ __forceinline__ unsigned xb_add(unsigned* p, unsigned v) { return __hip_atomic_fetch_add(p, v, __ATOMIC_RELAXED, __HIP_MEMORY_SCOPE_AGENT); }
__device__ __forceinline__ unsigned xb_xcc_id() { return (unsigned)__builtin_amdgcn_s_getreg((3 << 11) | 20) & 0xFu; }
#define XB_SPIN(cond, bar) do { unsigned _sp = 0; while (cond) { __builtin_amdgcn_s_sleep(1); \
    if ((++_sp & 255u) == 0u) { if (xb_ld(&(bar)[XB_TMO])) break; if (_sp > XB_SPIN_CAP) { atomicAdd(&(bar)[XB_TMO], 1u); break; } } } } while (0)

struct XcdBarrier {
    unsigned* bar; unsigned x;
    volatile LAS unsigned* st;
};

__device__ __forceinline__ XcdBarrier xcd_barrier_post(unsigned* bar, volatile LAS unsigned* st) {
    XcdBarrier b; b.bar = bar; b.x = xb_xcc_id(); b.st = st;
    if (threadIdx.x == 0) (void)xb_add(&bar[XB_XCNT(b.x)], 1u);
    return b;
}
__device__ __forceinline__ void xcd_barrier_complete(unsigned* bar, unsigned x, unsigned& nloc, unsigned& nx) {
    const unsigned G = gridDim.x * gridDim.y * gridDim.z;
    unsigned sum, cnt, mine, sp = 0u;
    for (;;) {
        sum = 0u; cnt = 0u; mine = 0u;
#pragma unroll
        for (unsigned j = 0; j < 16; ++j) { const unsigned c = xb_ld(&bar[XB_XCNT(j)]); sum += c; cnt += (c > 0u) ? 1u : 0u; mine = (j == x) ? c : mine; }
        if (sum == G) break;
        __builtin_amdgcn_s_sleep(1);
        if ((++sp & 255u) == 0u) { if (xb_ld(&bar[XB_TMO])) break; if (sp > XB_SPIN_CAP) { atomicAdd(&bar[XB_TMO], 1u); break; } }
    }
    nloc = mine > 0u ? mine : 1u; nx = cnt > 0u ? cnt : 1u;
}

__device__ __forceinline__ void xcd_barrier(const XcdBarrier& b) {
    asm volatile("s_waitcnt vmcnt(0)" ::: "memory");
    __syncthreads();
    if (threadIdx.x == 0) {
        unsigned* bar = b.bar;
        __builtin_amdgcn_s_waitcnt(0);
        unsigned nloc = b.st[0], nx = b.st[1];
        if (nloc == 0u) { xcd_barrier_complete(bar, b.x, nloc, nx); b.st[0] = nloc; b.st[1] = nx; }
        const unsigned old = xb_add(&bar[XB_XSUB(b.x)], 1u);
        const unsigned gen = old / nloc;
        if (old + 1u == (gen + 1u) * nloc) {
            __builtin_amdgcn_fence(__ATOMIC_RELEASE, "agent");
            asm volatile("s_waitcnt vmcnt(0)" ::: "memory");
            const unsigned og = xb_add(&bar[XB_TOP], 1u);
            const unsigned tg = og / nx;
            if (og + 1u == (tg + 1u) * nx) xb_add(&bar[XB_TOPGEN], 1u);
            else XB_SPIN(xb_ld(&bar[XB_TOPGEN]) == tg, bar);
            __builtin_amdgcn_fence(__ATOMIC_ACQUIRE, "agent");
            xb_add(&bar[XB_XGEN(b.x)], 1u);
            asm volatile("s_waitcnt vmcnt(0)" ::: "memory");
        } else {
            XB_SPIN(xb_ld(&bar[XB_XGEN(b.x)]) == gen, bar);
            __builtin_amdgcn_fence(__ATOMIC_ACQUIRE, "agent");
            asm volatile("s_waitcnt vmcnt(0)" ::: "memory");
        }
    }
    __syncthreads();
}

__device__ __forceinline__ unsigned char* launder(unsigned char* p) { asm volatile("" : "+s"(p)); return p; }
struct Args { const float* in[23]; float* out; unsigned char* ws; };

template <int SRC, int EXTRA>
__device__ __forceinline__ void ln_phase(LAS unsigned char* lds, int G, const float* src, const pg8::PrevLN hp, const float* ys, const int* pos, const float* gwt, const int* tailid, const float* part,
                                         const float* g, const float* b, float* of32, float* stats, bf16* obf, const float* w8, int w8ld, const float* bf8, float* logf, int* eidx, float* gwout, unsigned* gcount) {
    int tid = threadIdx.x; asm volatile("" : "+v"(tid)); const int lane = tid & 63, wave = tid >> 6;
    LAS float* w8s = (LAS float*)lds;
    LAS unsigned* lcnt = (LAS unsigned*)(lds + 32768);
    if (EXTRA != 0) { for (int i = tid; i < 8192; i += NT) { const int k = i >> 3, j = i & 7; w8s[j * 1024 + k] = w8[(size_t)k * w8ld + j]; } if (tid < 8) lcnt[tid] = 0u; __syncthreads(); }
    f32x4 gv[4], bv[4];
#pragma unroll
    for (int j = 0; j < 4; ++j) { gv[j] = *(const f32x4*)(g + 256 * j + 4 * lane); bv[j] = *(const f32x4*)(b + 256 * j + 4 * lane); }
    const int gw = blockIdx.x * NWAVES + wave, NGW = G * NWAVES;
    for (int row = gw; row < M; row += NGW) {
        f32x4 v[4];
        if (SRC == 0) {
#pragma unroll
            for (int j = 0; j < 4; ++j) v[j] = *(const f32x4*)(src + (size_t)row * 1024 + 256 * j + 4 * lane);
        } else {
            const int p0 = pos[2 * row], p1 = pos[2 * row + 1]; const float w0 = gwt[2 * row], w1 = gwt[2 * row + 1]; const float hm = hp.stats[2 * row], hr = hp.stats[2 * row + 1];
#pragma unroll
            for (int j = 0; j < 4; ++j) { const f32x4 a = (*(const f32x4*)(hp.src + (size_t)row * 1024 + 256 * j + 4 * lane) - hm) * hr * *(const f32x4*)(hp.g + 256 * j + 4 * lane) + *(const f32x4*)(hp.b + 256 * j + 4 * lane);
                f32x4 y[2];
#pragma unroll
                for (int q = 0; q < 2; ++q) { const int p = q ? p1 : p0; const int t = __builtin_amdgcn_readfirstlane(tailid[(p >> 8) * 4 + j]);
                    if (t < 0) y[q] = *(const f32x4*)(ys + (size_t)p * 1024 + 256 * j + 4 * lane);
                    else { f32x4 acc = (f32x4){0.f, 0.f, 0.f, 0.f};
#pragma unroll
                        for (int sl = 0; sl < 7; ++sl) acc = acc + *(const f32x4*)(part + ((size_t)(t * 7 + sl) * 256 + (p & 255)) * 256 + 4 * lane);
                        y[q] = acc; } }
                v[j] = a * ALPHA + y[0] * w0 + y[1] * w1; }
        }
        float s = 0.f;
#pragma unroll
        for (int j = 0; j < 4; ++j) s += (v[j].x + v[j].y) + (v[j].z + v[j].w);
        const float mean = wave_sum(s) * (1.f / 1024.f); float s2 = 0.f;
#pragma unroll
        for (int j = 0; j < 4; ++j) { v[j] = v[j] - mean; s2 += (v[j].x * v[j].x + v[j].y * v[j].y) + (v[j].z * v[j].z + v[j].w * v[j].w); }
        const float rstd = 1.f / sqrtf(wave_sum(s2) * (1.f / 1024.f) + LN_EPS);
        if (stats && lane == 0) { stats[2 * row] = mean; stats[2 * row + 1] = rstd; }
#pragma unroll
        for (int j = 0; j < 4; ++j) { v[j] = v[j] * rstd * gv[j] + bv[j]; if (of32) *(f32x4*)(of32 + (size_t)row * 1024 + 256 * j + 4 * lane) = v[j];
            if (obf) { v2u o; o.x = pk2(v[j].x, v[j].y); o.y = pk2(v[j].z, v[j].w); *(v2u*)(obf + (size_t)row * 1024 + 256 * j + 4 * lane) = o; } }
        if (EXTRA != 0) {
            float d[8];
#pragma unroll
            for (int e = 0; e < 8; ++e) { float a = 0.f;
#pragma unroll
                for (int j = 0; j < 4; ++j) { const f32x4 w = *(const LAS f32x4*)(w8s + e * 1024 + 256 * j + 4 * lane); a += (v[j].x * w.x + v[j].y * w.y) + (v[j].z * w.z + v[j].w * w.w); }
                d[e] = wave_sum(a); }
            if (EXTRA == 1) {
                float x = d[0];
#pragma unroll
                for (int e = 1; e < 8; ++e) x = (lane == e) ? d[e] : x;
                if (lane < 8) { x += bf8[lane]; const float ls = (x >= 0.f) ? -log1pf(__expf(-x)) : (x - log1pf(__expf(x))); logf[(size_t)lane * M + row] = ls; }
            } else {
                int i0 = 0; float v0 = d[0];
#pragma unroll
                for (int e = 1; e < 8; ++e) if (d[e] > v0) { v0 = d[e]; i0 = e; }
                int i1 = -1; float v1 = -INFINITY;
#pragma unroll
                for (int e = 0; e < 8; ++e) if (e != i0 && d[e] > v1) { v1 = d[e]; i1 = e; }
                if (lane == 0) { const float w0 = 1.f / (1.f + __expf(v1 - v0)); eidx[row] = i0 | (i1 << 8); gwout[2 * row] = w0; gwout[2 * row + 1] = 1.f - w0;
                    atomicAdd((unsigned*)&lcnt[i0], 1u); atomicAdd((unsigned*)&lcnt[i1], 1u); }
            }
        }
    }
    if (EXTRA == 2) { __syncthreads(); if (tid < 8) atomicAdd(gcount + tid, lcnt[tid]); }
}

#define GSYNC_CG() do { if constexpr (SEL < 0) cg::this_grid().sync(); } while (0)
#define GSYNC() do { if constexpr (SEL < 0) { XcdBarrier b_; b_.bar = (unsigned*)(launder(args.ws) + WS_BAR); b_.x = xb_xcc_id(); b_.st = (volatile LAS unsigned*)(ldsp + attn_body::LDS_BYTES); xcd_barrier(b_); } } while (0)
#define PHASE(id) if constexpr (SEL < 0 || SEL == (id))
#ifndef PHM
#define PHM 0xffffffffu
#endif
#ifndef REP_G
#define REP_G 1
#endif
#ifndef REP_A
#define REP_A 1
#endif
#ifndef REP_P
#define REP_P 1
#endif
#define GEMM_PHASE(EpiT, SchedT, gg, SS, EE) do { pg8::gemm_phase<EpiT, SchedT, true, true>(ldsp, gg, SS, EE); if constexpr (REP_G > 1) { pg8::gemm_phase<EpiT, SchedT, true, true>(ldsp, gg, SS, EE); } } while (0)

#define q_ctl ((unsigned*)(launder(args.ws) + WS_CTL))
#define q_logf ((float*)(launder(args.ws) + WS_LOGF))
#define q_cum ((float*)(launder(args.ws) + WS_CUM))
#define q_eidx ((int*)(launder(args.ws) + WS_EIDX))
#define q_gwt ((float*)(launder(args.ws) + WS_GW))
#define q_pos ((int*)(launder(args.ws) + WS_POS))
#define q_tile_e ((int*)(launder(args.ws) + WS_TILEE))
#define q_Win_t ((bf16*)(launder(args.ws) + WS_WIN))
#define q_Wbr_t ((bf16*)(launder(args.ws) + WS_WBR))
#define q_Wo_t ((bf16*)(launder(args.ws) + WS_WO))
#define q_Wgu_t ((bf16*)(launder(args.ws) + WS_WGU))
#define q_Wdn_t ((bf16*)(launder(args.ws) + WS_WDN))
#define q_Wegu_t ((bf16*)(launder(args.ws) + WS_WEGU))
#define q_Wedn_t ((bf16*)(launder(args.ws) + WS_WEDN))
#define q_h ((float*)(launder(args.ws) + WS_H))
#define q_stats ((float*)(launder(args.ws) + WS_STATS))
#define q_hb ((bf16*)(launder(args.ws) + WS_HB))
#define q_proj ((bf16*)(launder(args.ws) + WS_PROJ))
#define q_yatt ((bf16*)(launder(args.ws) + WS_YATT))
#define q_odiff ((bf16*)(launder(args.ws) + WS_ODIFF))
#define q_Tb ((float*)(launder(args.ws) + WS_T))
#define q_merged ((bf16*)(launder(args.ws) + WS_MERGED))
#define q_z ((float*)(launder(args.ws) + WS_Z))
#define q_act ((bf16*)(launder(args.ws) + WS_ACT))
#define q_Xs ((bf16*)(launder(args.ws) + WS_XS))
#define q_acts ((bf16*)(launder(args.ws) + WS_ACTS))
#define q_ys ((float*)(launder(args.ws) + WS_YS))
#define in args.in

__device__ __forceinline__ int tid_fresh() { int t = threadIdx.x; asm volatile("" : "+v"(t)); return t; }
#define FRESH_IDS() const int tid = tid_fresh(), lane = tid & 63, wave = __builtin_amdgcn_readfirstlane(tid >> 6)
template <int l, int SEL> __device__ __forceinline__ void layer_body(const Args& args, LAS unsigned char* ldsp, unsigned char* lds, const int G, const int bx, const int vcu) {
        constexpr int B = 1 + 10 * l;
        PHASE(B + 0) {
        if (bx < 8) {
            FRESH_IDS();
            const float* lf = q_logf + (size_t)bx * M + 32 * tid; float* co = q_cum + (size_t)bx * M + 32 * tid;
            f32x4 v[8]; float run = 0.f;
#pragma unroll
            for (int j = 0; j < 8; ++j) { v[j] = *(const f32x4*)(lf + 4 * j); v[j].x += run; v[j].y += v[j].x; v[j].z += v[j].y; v[j].w += v[j].z; run = v[j].w; }
            float inc = run;
#pragma unroll
            for (int o = 1; o < 64; o <<= 1) { const float t = __shfl_up(inc, o); if (lane >= o) inc += t; }
            LAS float* wt = (LAS float*)ldsp;
            if (lane == 63) wt[wave] = inc;
            __syncthreads();
            float base = inc - run;
            for (int w = 0; w < wave; ++w) base += wt[w];
#pragma unroll
            for (int j = 0; j < 8; ++j) *(f32x4*)(co + 4 * j) = v[j] + base;
            __syncthreads();
        }
        {
            pg8::Gemm g{q_hb, q_Win_t + (size_t)l * NPROJ * 1024, M, NPROJ, 1024}; pg8::StaticOrder S; S.init(M, NPROJ, G, bx);
            pg8::EpiProj E{q_proj, attn_body::C2, q_ctl + 16};
            if (PHM & (1u << 1)) GEMM_PHASE(pg8::EpiProj, pg8::StaticOrder, g, S, E);
#ifdef REP_INPROJ
            GEMM_PHASE(pg8::EpiProj, pg8::StaticOrder, g, S, E);
#endif
        }
        }
        GSYNC();

        PHASE(B + 1) {
            typedef attn_body::bf16 abf;
            const abf* pj = (const abf*)q_proj;
#ifndef NO_ATTN0
            for (int p = vcu; p < 256; p += G) { const int vh = p >> 5, s = p & 31;
                const unsigned* nr = q_ctl + 16; const float qn = sqrtf(__uint_as_float(nr[2 * vh]) + __uint_as_float(nr[2 * vh + 1])), kn = sqrtf(__uint_as_float(nr[16 + 2 * vh]) + __uint_as_float(nr[16 + 2 * vh + 1]));
                const float thr = 2.04f * qn * kn + 40.f;
                for (int half = 0; half < 2; ++half) { const int qb = half ? 63 - s : s;
                    attn_body::attn_unit<0, 8>(qb, pj + (size_t)vh * M * 64, pj + (size_t)(8 + vh) * M * 64, pj + (size_t)(16 + vh) * M * 64, (abf*)q_yatt + vh * 64, q_cum + (size_t)vh * M, nullptr, thr, (char*)lds); } }
#endif
#ifndef NO_ATTN1
            for (int p = 256 + vcu; p < 512; p += G) { const int d = (p >> 5) - 8, s = p & 31, hd = d >> 1, c = d & 1;
                for (int half = 0; half < 2; ++half) { const int qb = half ? 63 - s : s;
                    attn_body::attn_unit_d<8>(qb, pj + (size_t)(24 + d) * M * 64, pj + (size_t)(32 + d) * M * 64, pj + (size_t)5 * 512 * M + (size_t)hd * M * 128, (abf*)q_odiff + (size_t)c * M * 512 + hd * 128, nullptr, in[15] + hd, 0.f, (char*)lds); } }
#endif
            if constexpr (REP_A > 1) {
#ifndef NO_DUP0
            for (int p = vcu; p < 256; p += G) { const int vh = p >> 5, s = p & 31;
                const unsigned* nr = q_ctl + 16; const float qn = sqrtf(__uint_as_float(nr[2 * vh]) + __uint_as_float(nr[2 * vh + 1])), kn = sqrtf(__uint_as_float(nr[16 + 2 * vh]) + __uint_as_float(nr[16 + 2 * vh + 1]));
                const float thr = 2.04f * qn * kn + 40.f;
                for (int half = 0; half < 2; ++half) { const int qb = half ? 63 - s : s;
                    attn_body::attn_unit<0, 8>(qb, pj + (size_t)vh * M * 64, pj + (size_t)(8 + vh) * M * 64, pj + (size_t)(16 + vh) * M * 64, (abf*)q_yatt + vh * 64, q_cum + (size_t)vh * M, nullptr, thr, (char*)lds); } }
#endif
#ifndef NO_DUP1
            for (int p = 256 + vcu; p < 512; p += G) { const int d = (p >> 5) - 8, s = p & 31, hd = d >> 1, c = d & 1;
                for (int half = 0; half < 2; ++half) { const int qb = half ? 63 - s : s;
                    attn_body::attn_unit_d<8>(qb, pj + (size_t)(24 + d) * M * 64, pj + (size_t)(32 + d) * M * 64, pj + (size_t)5 * 512 * M + (size_t)hd * M * 128, (abf*)q_odiff + (size_t)c * M * 512 + hd * 128, nullptr, in[15] + hd, 0.f, (char*)lds); } }
#endif
            }
        }
        GSYNC();

        PHASE(B + 2) {
            FRESH_IDS();
            const float lam_init = 0.8f - 0.6f * expf(-0.3f * (float)l);
            const float a1 = wave_sum(in[5][l * 64 + lane] * in[6][l * 64 + lane]), a2 = wave_sum(in[7][l * 64 + lane] * in[8][l * 64 + lane]);
            const float lam = expf(a1) - expf(a2) + lam_init;
            const float* sg = in[9] + l * 128 + (lane & 15) * 8; float gsc[8];
#pragma unroll
            for (int i = 0; i < 8; ++i) gsc[i] = sg[i] * (1.f - lam_init);
            const int gw = bx * NWAVES + wave, NGW = G * NWAVES;
            for (int row = gw; row < M; row += NGW) {
                const v4u a = *(const v4u*)(q_odiff + (size_t)row * 512 + 8 * lane), b = *(const v4u*)(q_odiff + (size_t)(M + row) * 512 + 8 * lane);
                float o[8]; const unsigned aw[4] = {a.x, a.y, a.z, a.w}, bw[4] = {b.x, b.y, b.z, b.w};
#pragma unroll
                for (int i = 0; i < 4; ++i) { o[2 * i] = pg8::bf_lo(aw[i]) - lam * pg8::bf_lo(bw[i]); o[2 * i + 1] = pg8::bf_hi(aw[i]) - lam * pg8::bf_hi(bw[i]); }
                float ss = 0.f;
#pragma unroll
                for (int i = 0; i < 8; ++i) ss += o[i] * o[i];
                ss += __shfl_xor(ss, 1); ss += __shfl_xor(ss, 2); ss += __shfl_xor(ss, 4); ss += __shfl_xor(ss, 8);
                const float r = 1.f / sqrtf(ss * (1.f / 128.f) + SUBLN_EPS);
                v4u w; w.x = pk2(o[0] * r * gsc[0], o[1] * r * gsc[1]); w.y = pk2(o[2] * r * gsc[2], o[3] * r * gsc[3]); w.z = pk2(o[4] * r * gsc[4], o[5] * r * gsc[5]); w.w = pk2(o[6] * r * gsc[6], o[7] * r * gsc[7]);
                *(v4u*)(q_yatt + (size_t)(M + row) * 512 + 8 * lane) = w;
            }
        }
        GSYNC();

        PHASE(B + 3) {
            pg8::Gemm g{q_yatt, q_Wbr_t + (size_t)l * 2048 * 512, 2 * M, 2048, 512}; pg8::MergeOrder S; S.b.init(M, 1024, G, bx);
            pg8::EpiMerge E{q_proj, q_Tb, q_merged};
            if (PHM & (1u << 2)) GEMM_PHASE(pg8::EpiMerge, pg8::MergeOrder, g, S, E);
        }
        GSYNC();
        PHASE(B + 4) {
            pg8::Gemm g{q_merged, q_Wo_t + (size_t)l * 1024 * 1024, M, 1024, 1024}; pg8::StaticOrder S; S.init(M, 1024, G, bx);
            pg8::EpiResid E{l == 0 ? pg8::PrevLN{in[0], q_stats, in[1], in[2]} : pg8::PrevLN{q_z, q_stats, in[21], in[22]}, q_z, ALPHA};
            if (PHM & (1u << 3)) GEMM_PHASE(pg8::EpiResid, pg8::StaticOrder, g, S, E);
        }
        GSYNC();
        PHASE(B + 5) {
        if constexpr (l == 0) { if (PHM & (1u << 12)) ln_phase<0, 0>(ldsp, G, q_z, pg8::PrevLN{nullptr, nullptr, nullptr, nullptr}, nullptr, nullptr, nullptr, nullptr, nullptr, in[13], in[14], nullptr, q_stats, q_hb, nullptr, 0, nullptr, nullptr, nullptr, nullptr, nullptr); }
        else { if (PHM & (1u << 13)) ln_phase<0, 2>(ldsp, G, q_z, pg8::PrevLN{nullptr, nullptr, nullptr, nullptr}, nullptr, nullptr, nullptr, nullptr, nullptr, in[13] + 1024, in[14] + 1024, nullptr, q_stats, q_hb, in[18], 8, nullptr, nullptr, q_eidx, q_gwt, q_ctl); }
        }
        GSYNC();

        if constexpr (l == 0) {
            PHASE(B + 6) {
                pg8::Gemm g{q_hb, q_Wgu_t, M, 2 * DFF, 1024}; pg8::StaticOrder S; S.init(M, 2 * DFF, G, bx);
                pg8::EpiSwiglu E{q_act, DFF, 1 << 20};
                if (PHM & (1u << 4)) GEMM_PHASE(pg8::EpiSwiglu, pg8::StaticOrder, g, S, E);
            }
            GSYNC();
            PHASE(B + 7) {
                pg8::Gemm g{q_act, q_Wdn_t, M, 1024, DFF}; pg8::StaticOrder S; S.init(M, 1024, G, bx);
                pg8::EpiResid E{pg8::PrevLN{q_z, q_stats, in[13], in[14]}, q_z, ALPHA};
                if (PHM & (1u << 5)) GEMM_PHASE(pg8::EpiResid, pg8::StaticOrder, g, S, E);
            }
            GSYNC();
            PHASE(B + 8) if (PHM & (1u << 14)) ln_phase<0, 1>(ldsp, G, q_z, pg8::PrevLN{nullptr, nullptr, nullptr, nullptr}, nullptr, nullptr, nullptr, nullptr, nullptr, in[21], in[22], nullptr, q_stats, q_hb, in[3] + (size_t)1024 * NIN + 1536, NIN, in[4] + 8, q_logf, nullptr, nullptr, nullptr);
            GSYNC();
        } else {
            PHASE(B + 6) {
                FRESH_IDS();
                LAS int* li = (LAS int*)ldsp;
                if (tid < 8) { li[tid] = 0; li[32 + tid] = (int)q_ctl[tid]; }
                __syncthreads();
                if (tid == 0) { int o = 0; for (int e = 0; e < 8; ++e) { li[16 + e] = o; o += (li[32 + e] + 255) & ~255; } li[24] = o; }
                __syncthreads();
                const int npad_rows = li[24];
                if (bx == 0) { for (int t = tid; t < 240; t += NT) { int e = 0; for (int q = 1; q < 8; ++q) if (t * 256 >= li[16 + q]) e = q; q_tile_e[t] = e; } if (tid == 0) q_tile_e[255] = npad_rows / 256; }
                for (int tb = bx * 64; tb < M; tb += G * 64) {
                    int e = 0, r = 0, tok = 0;
                    if (tid < 128) { tok = tb + (tid >> 1); const int ei = q_eidx[tok]; e = (tid & 1) ? (ei >> 8) & 0xff : ei & 0xff; r = atomicAdd((int*)&li[e], 1); }
                    __syncthreads();
                    if (tid < 8) { li[8 + tid] = (int)atomicAdd(q_ctl + 8 + tid, (unsigned)li[tid]); }
                    __syncthreads();
                    if (tid < 128) { const int p = li[16 + e] + li[8 + e] + r; q_pos[2 * tok + (tid & 1)] = p; ((LAS int*)ldsp)[64 + tid] = p; }
                    __syncthreads();
                    if (tid < 8) li[tid] = 0;
                    for (int sidx = wave; sidx < 128; sidx += NWAVES) { const int p = ((LAS int*)ldsp)[64 + sidx]; const int tk = tb + (sidx >> 1);
#pragma unroll
                        for (int q = 0; q < 2; ++q) *(v4u*)(q_Xs + (size_t)p * 1024 + 512 * q + 8 * lane) = *(const v4u*)(q_hb + (size_t)tk * 1024 + 512 * q + 8 * lane); }
                    __syncthreads();
                }
                if (bx == 0) {
                    const int nMt = npad_rows / 256, nwg = nMt * 4, lim = pg8::main_units(nwg, G); int* tl = q_tile_e + 8192;
                    pg8::i32x4* tm = (pg8::i32x4*)(q_tile_e + 1024); pg8::i32x4* tt = (pg8::i32x4*)(q_tile_e + 4096);
                    for (int t = tid; t < nwg; t += NT) tl[t] = -1;
                    __syncthreads();
                    for (int L = tid; L < nwg; L += NT) { pg8::Unit u; pg8::map_unit(L, nMt, 4, u); int e = 0; for (int q = 1; q < 8; ++q) if (u.pm * 256 >= li[16 + q]) e = q;
                        if (L < lim) tm[L] = (pg8::i32x4){u.pm, u.pn + 4 * e, 0, 0};
                        else { tl[u.pm * 4 + u.pn] = L - lim; for (int sl = 0; sl < pg8::TAIL_KS; ++sl) tt[(L - lim) * pg8::TAIL_KS + sl] = (pg8::i32x4){u.pm, u.pn + 4 * e, sl * pg8::TAIL_K, (L - lim) * pg8::TAIL_KS + sl}; } }
                    if (tid == 0) { q_tile_e[254] = lim; q_tile_e[253] = (nwg - lim) * pg8::TAIL_KS; }
                }
                for (int e = 0; e < 8; ++e) { const int c = li[32 + e], st = li[16 + e] + c, en = li[16 + e] + ((c + 255) & ~255);
                    for (int rr = st + bx * NWAVES + wave; rr < en; rr += G * NWAVES) {
#pragma unroll
                        for (int q = 0; q < 2; ++q) *(v4u*)(q_Xs + (size_t)rr * 1024 + 512 * q + 8 * lane) = (v4u){0u, 0u, 0u, 0u}; } }
            }
            GSYNC();
            PHASE(B + 7) {
                const int mrows = q_tile_e[255] * 256;
                pg8::Gemm g{q_Xs, q_Wegu_t, mrows, 2 * DFFE, 1024}; pg8::MoeOrder S; S.b.init(mrows, 2 * DFFE, G, bx); S.te = q_tile_e; S.nper = 28;
                pg8::EpiSwiglu E{q_acts, DFFE, 28};
                if (PHM & (1u << 6)) GEMM_PHASE(pg8::EpiSwiglu, pg8::MoeOrder, g, S, E);
            }
            GSYNC();
            PHASE(B + 8) {
                const int mrows = q_tile_e[255] * 256, lim = q_tile_e[254], nsub = q_tile_e[253];
                {
                    pg8::Gemm g{q_acts, q_Wedn_t, mrows, 1024, DFFE}; pg8::TableOrder S{(const pg8::i32x4*)(q_tile_e + 1024), lim, G, bx};
                    pg8::EpiStoreF32 E{q_ys, 4};
                    if (PHM & (1u << 7)) GEMM_PHASE(pg8::EpiStoreF32, pg8::TableOrder, g, S, E);
                }
                if (nsub > 0) {
                    pg8::Gemm g{q_acts, q_Wedn_t, mrows, 1024, pg8::TAIL_K, DFFE}; pg8::TableOrder S{(const pg8::i32x4*)(q_tile_e + 4096), nsub, G, bx};
                    pg8::EpiStoreTail E{q_h};
                    GEMM_PHASE(pg8::EpiStoreTail, pg8::TableOrder, g, S, E);
                }
            }
            GSYNC();
            PHASE(B + 9) if (PHM & (1u << 15)) ln_phase<1, 0>(ldsp, G, nullptr, pg8::PrevLN{q_z, q_stats, in[13] + 1024, in[14] + 1024}, q_ys, q_pos, q_gwt, q_tile_e + 8192, q_h, in[21] + 1024, in[22] + 1024, args.out, nullptr, nullptr, nullptr, 0, nullptr, nullptr, nullptr, nullptr, nullptr);
        }
}

template <int SEL> __global__ void __launch_bounds__(NWAVES * 64, 2) fwd_kernel(Args args) {
    extern __shared__ __attribute__((aligned(16))) unsigned char lds[];
    LAS unsigned char* ldsp = (LAS unsigned char*)lds;
    const int G = gridDim.x, bx = blockIdx.x; const int vcu = (G % 8 == 0) ? (bx % 8) * (G / 8) + bx / 8 : bx;
    if constexpr (SEL < 0) { if (threadIdx.x < 2) ((volatile LAS unsigned*)(ldsp + attn_body::LDS_BYTES))[threadIdx.x] = 0u; __syncthreads();
        (void)xcd_barrier_post((unsigned*)(launder(args.ws) + WS_BAR), (volatile LAS unsigned*)(ldsp + attn_body::LDS_BYTES)); }
    PHASE(0) {
        FRESH_IDS();
        LAS float* scr = (LAS float*)(ldsp + wave * 16384);
        const int gw = vcu * NWAVES + wave, NGW = G * NWAVES;
        constexpr int I_A = 16 * 48, I_B = 16 * 112, I_BR = 8 * 32, I_O = 16 * 32, I_L = I_A + I_B + 2 * I_BR + I_O;
        constexpr int I_GU = 16 * 176, I_DN = 44 * 32, I_EGU = 16 * 224, I_EDN = 56 * 32;
        constexpr int NITEMS = 2 * I_L + I_GU + I_DN + 8 * I_EGU + 8 * I_EDN;
        _Pragma("nounroll") for (int repp_ = 0; repp_ < REP_P; ++repp_)
        for (int it = gw; it < NITEMS; it += NGW) {
            int r = it;
            if (r < 2 * I_L) { const int l = r / I_L; r -= l * I_L; const float* win = in[3] + (size_t)l * 1024 * NIN; bf16* wt = q_Win_t + (size_t)l * NPROJ * 1024;
                if (r < I_A) { tr_seg<0>(win, NIN, 1024, 0, 1536, wt, 0, 0, scr, r, lane); continue; } r -= I_A;
                if (r < I_B) { tr_seg<0>(win, NIN, 1024, 1544, 3584, wt, 1536, 0, scr, r, lane); continue; } r -= I_B;
                if (r < I_BR) { tr_seg<0>(in[10] + (size_t)l * 512 * 1024, 1024, 512, 0, 1024, q_Wbr_t + (size_t)l * 2048 * 512, 0, 0, scr, r, lane); continue; } r -= I_BR;
                if (r < I_BR) { tr_seg<0>(in[11] + (size_t)l * 512 * 1024, 1024, 512, 0, 1024, q_Wbr_t + (size_t)l * 2048 * 512, 1024, 0, scr, r, lane); continue; } r -= I_BR;
                tr_seg<0>(in[12] + (size_t)l * 1024 * 1024, 1024, 1024, 0, 1024, q_Wo_t + (size_t)l * 1024 * 1024, 0, 0, scr, r, lane); continue; }
            r -= 2 * I_L;
            if (r < I_GU) { tr_seg<1>(in[16], 2 * DFF, 1024, 0, 2 * DFF, q_Wgu_t, 0, DFF, scr, r, lane); continue; } r -= I_GU;
            if (r < I_DN) { tr_seg<0>(in[17], 1024, DFF, 0, 1024, q_Wdn_t, 0, 0, scr, r, lane); continue; } r -= I_DN;
            if (r < 8 * I_EGU) { const int e = r / I_EGU; r -= e * I_EGU; tr_seg<1>(in[19] + (size_t)e * 1024 * 2 * DFFE, 2 * DFFE, 1024, 0, 2 * DFFE, q_Wegu_t + (size_t)e * 2 * DFFE * 1024, 0, DFFE, scr, r, lane); continue; } r -= 8 * I_EGU;
            { const int e = r / I_EDN; r -= e * I_EDN; tr_seg<0>(in[20] + (size_t)e * DFFE * 1024, 1024, DFFE, 0, 1024, q_Wedn_t + (size_t)e * 1024 * DFFE, 0, 0, scr, r, lane); }
        }
        __syncthreads();
        if (PHM & (1u << 11)) ln_phase<0, 1>(ldsp, G, in[0], pg8::PrevLN{nullptr, nullptr, nullptr, nullptr}, nullptr, nullptr, nullptr, nullptr, nullptr, in[1], in[2], nullptr, q_stats, q_hb, in[3] + 1536, NIN, in[4], q_logf, nullptr, nullptr, nullptr);
    }
    GSYNC_CG();

    layer_body<0, SEL>(args, ldsp, lds, G, bx, vcu);
    layer_body<1, SEL>(args, ldsp, lds, G, bx, vcu);
}

#undef q_ctl
#undef q_logf
#undef q_cum
#undef q_eidx
#undef q_gwt
#undef q_pos
#undef q_tile_e
#undef q_Win_t
#undef q_Wbr_t
#undef q_Wo_t
#undef q_Wgu_t
#undef q_Wdn_t
#undef q_Wegu_t
#undef q_Wedn_t
#undef q_h
#undef q_stats
#undef q_hb
#undef q_proj
#undef q_yatt
#undef q_odiff
#undef q_Tb
#undef q_merged
#undef q_z
#undef q_act
#undef q_Xs
#undef q_acts
#undef q_ys
#undef in
#ifndef N_LAUNCH_MODE
#define N_LAUNCH_MODE 0
#endif
template <int S> static void launch_sel(int grid, Args& a, hipStream_t stream) {
    static bool attr = false;
    if (!attr) { (void)hipFuncSetAttribute((const void*)fwd_kernel<S>, hipFuncAttributeMaxDynamicSharedMemorySize, LDS_BYTES); attr = true; }
    hipLaunchKernelGGL(fwd_kernel<S>, dim3(grid), dim3(NWAVES * 64), LDS_BYTES, stream, a);
}
template <int S> static void launch_all(int grid, Args& a, hipStream_t stream) {
    if constexpr (S <= 20) { if constexpr (S != 10) launch_sel<S>(grid, a, stream); launch_all<S + 1>(grid, a, stream); }
}
extern "C" void kernel_launch(void* const* d_in, const int* in_sizes, int n_in, void* d_out, int out_size, void* d_ws, size_t ws_size, hipStream_t stream) {
    static int grid = 0;
    if (grid == 0) {
        if (n_in != 23 || out_size != M * DMODEL || ws_size < WS_END) { fprintf(stderr, "kernel_launch: unexpected shapes (n_in %d, out %d, ws %zu)\n", n_in, out_size, ws_size); grid = -1; return; }
        int dev = 0, cus = 0;
        (void)hipGetDevice(&dev); (void)hipDeviceGetAttribute(&cus, hipDeviceAttributeMultiprocessorCount, dev);
#if N_LAUNCH_MODE == 0
        int per_cu = 0;
        if (hipFuncSetAttribute((const void*)fwd_kernel<-1>, hipFuncAttributeMaxDynamicSharedMemorySize, LDS_BYTES) != hipSuccess) { fprintf(stderr, "kernel_launch: hipFuncSetAttribute failed\n"); grid = -1; return; }
        if (hipOccupancyMaxActiveBlocksPerMultiprocessor(&per_cu, (const void*)fwd_kernel<-1>, NWAVES * 64, LDS_BYTES) != hipSuccess || per_cu < 1) { fprintf(stderr, "kernel_launch: occupancy query says %d\n", per_cu); }
        (void)hipGetLastError();
#endif
        grid = cus;
    }
    if (grid < 0) return;
    (void)hipMemsetAsync((char*)d_ws + WS_CTL, 0, 32768, stream);
    Args a{};
    for (int i = 0; i < 23; ++i) a.in[i] = (const float*)d_in[i];
    a.out = (float*)d_out; a.ws = (unsigned char*)d_ws;
#if N_LAUNCH_MODE == 0
    void* kargs[] = {&a};
    hipError_t e = hipLaunchCooperativeKernel((const void*)fwd_kernel<-1>, dim3(grid), dim3(NWAVES * 64), kargs, LDS_BYTES, stream);
    if (e != hipSuccess) fprintf(stderr, "cooperative launch failed: %s (grid %d)\n", hipGetErrorString(e), grid);
#else
    launch_all<0>(grid, a, stream);
#endif
}
```

```cpp
#include <hip/hip_runtime.h>
#include <hip/hip_cooperative_groups.h>
#include <hip/hip_bf16.h>
#include <cstdio>
#include <cstdint>
#include <cmath>
namespace cg = cooperative_groups;
__device__ __forceinline__ int lane_now() { int l; asm volatile("v_mbcnt_lo_u32_b32 %0, -1, 0\n\tv_mbcnt_hi_u32_b32 %0, -1, %0" : "=v"(l)); return l; }
__device__ __forceinline__ int mk_tid(int wv) { return (wv << 6) | lane_now(); }
__device__ __forceinline__ float shx(float v, int o) { const int l = lane_now(); return __int_as_float(__builtin_amdgcn_ds_bpermute((l ^ o) << 2, __float_as_int(v))); }
namespace pg8 {
#define PG8_LAS __attribute__((address_space(3)))
typedef unsigned short bf16_t;
typedef short bf16x8 __attribute__((ext_vector_type(8)));
typedef float f32x4 __attribute__((ext_vector_type(4)));
typedef unsigned u32x4 __attribute__((ext_vector_type(4)));
constexpr int BM = 256, BK = 64, HALF = 128, HTB = HALF * BK * 2  , STAGE_BYTES = 8 * HTB, NXCD = 8, WGM = 8;

__host__ __device__ __forceinline__ int lds_byte(int r, int c) { const int st = (r >> 4) * 2 + (c >> 5), rr = r & 15, cc = c & 31, ob = rr * 64 + cc * 2; return st * 1024 + (ob ^ (((ob >> 9) & 1) << 5)); }
__host__ __device__ __forceinline__ void stage_rc(int b, int& R, int& C) { const int st = b / 1024, sb = b % 1024, swz = sb ^ (((sb >> 9) & 1) << 5); R = (st >> 1) * 16 + swz / 64; C = (st & 1) * 32 + (swz % 64) / 2; }
__host__ __device__ __forceinline__ int perm32(int rho) { const int n = rho >> 4, i = rho & 15; return 8 * (i >> 2) + 4 * n + (i & 3); }

struct Unit { int pm, pn; int koff = 0; int aux = 0; };
struct Gemm { const bf16_t* A; const bf16_t* Bt; int M, N, K; int ld = 0; };

struct StaticOrder {
    int nM, nN, nwg, G, c;
    __host__ __device__ void init(int M, int N, int G_, int c_) { nM = M / BM; nN = N / BM; nwg = nM * nN; G = G_; c = c_; }
    __host__ __device__ bool next(int i, Unit& u) const {
        const long L = (long)i * G + c; if (L >= nwg) return false;
        int wgid = (int)L; { const int q = nwg / NXCD, r = nwg % NXCD, xcd = wgid % NXCD, off = wgid / NXCD; wgid = (xcd < r ? xcd * (q + 1) : r * (q + 1) + (xcd - r) * q) + off; }
        const int nig = WGM * nN, gid = wgid / nig, fm = gid * WGM, gsz = (nM - fm) < WGM ? (nM - fm) : WGM;
        u.pm = fm + ((wgid % nig) % gsz); u.pn = (wgid % nig) / gsz; return true;
    }
    __device__ __forceinline__ void a_ready(const Unit&) const {}
    __device__ __forceinline__ void done(const Unit&) const {}
};

__device__ __forceinline__ unsigned cvt_pk_bf16(float lo, float hi) { unsigned r; asm volatile("v_cvt_pk_bf16_f32 %0, %1, %2" : "=v"(r) : "v"(lo), "v"(hi)); return r; }
__device__ __forceinline__ float sigm(float x) { return __builtin_amdgcn_rcpf(1.f + __builtin_amdgcn_exp2f(-1.4426950408889634f * x)); }
__device__ __forceinline__ float bf_lo(unsigned w) { return __uint_as_float(w << 16); }
__device__ __forceinline__ float bf_hi(unsigned w) { return __uint_as_float(w & 0xffff0000u); }
constexpr int NPROJ = 5120, M_ROWS = 16384;
struct EpiProj {
    static constexpr bool PERM = true, AFTER_DRAIN = false;
    bf16_t* O; float qscale; unsigned* nrm;
    __device__ __forceinline__ void operator()(const f32x4 (&acc)[2][2][4][2], const Unit& u, int wr, int wc, int fr, int fq) const {
        const int pn = u.pn; const float sc = (pn < 2 || (pn >= 6 && pn < 8)) ? qscale : 1.f; const bool gate = pn >= 12;
        const int row0 = u.pm * BM + wr * 64 + fr;
        const int seg = pn >> 1;
#pragma unroll
        for (int ai = 0; ai < 2; ++ai)
#pragma unroll
            for (int m = 0; m < 4; ++m) { const size_t row = (size_t)(row0 + ai * HALF + m * 16);
#pragma unroll
                for (int bj = 0; bj < 2; ++bj) { f32x4 v0 = acc[ai][bj][m][0], v1 = acc[ai][bj][m][1];
                    if (gate) { v0 = (f32x4){sigm(v0[0]), sigm(v0[1]), sigm(v0[2]), sigm(v0[3])}; v1 = (f32x4){sigm(v1[0]), sigm(v1[1]), sigm(v1[2]), sigm(v1[3])}; }
                    else { v0 = v0 * sc; v1 = v1 * sc; }
                    u32x4 w; w.x = cvt_pk_bf16(v0[0], v0[1]); w.y = cvt_pk_bf16(v0[2], v0[3]); w.z = cvt_pk_bf16(v1[0], v1[1]); w.w = cvt_pk_bf16(v1[2], v1[3]);
                    const int g64 = 4 * (pn & 1) + 2 * bj + (wc >> 1), cin = 32 * (wc & 1) + 8 * fq;
                    bf16_t* dst;
                    if (gate) dst = O + (size_t)6 * 512 * M_ROWS + row * 2048 + (pn - 12) * BM + bj * HALF + wc * 32 + 8 * fq;
                    else if (seg == 5) dst = O + (size_t)5 * 512 * M_ROWS + ((size_t)(g64 >> 1) * M_ROWS + row) * 128 + 64 * (g64 & 1) + cin;
                    else dst = O + (size_t)seg * 512 * M_ROWS + ((size_t)g64 * M_ROWS + row) * 64 + cin;
                    *(u32x4*)dst = w; } }
        if (pn < 4) {
            float mx[2] = {0.f, 0.f};
#pragma unroll
            for (int ai = 0; ai < 2; ++ai)
#pragma unroll
                for (int m = 0; m < 4; ++m)
#pragma unroll
                    for (int bj = 0; bj < 2; ++bj) { const f32x4 v0 = acc[ai][bj][m][0] * sc, v1 = acc[ai][bj][m][1] * sc;
                        float ss = (v0[0] * v0[0] + v0[1] * v0[1]) + (v0[2] * v0[2] + v0[3] * v0[3]) + (v1[0] * v1[0] + v1[1] * v1[1]) + (v1[2] * v1[2] + v1[3] * v1[3]);
                        ss += shx(ss, 16); ss += shx(ss, 32); mx[bj] = fmaxf(mx[bj], ss); }
#pragma unroll
            for (int bj = 0; bj < 2; ++bj) { float v = mx[bj]; v = fmaxf(v, shx(v, 1)); v = fmaxf(v, shx(v, 2)); v = fmaxf(v, shx(v, 4)); v = fmaxf(v, shx(v, 8));
                if (fr == 0 && fq == 0) atomicMax(nrm + (pn >> 1) * 16 + (4 * (pn & 1) + 2 * bj + (wc >> 1)) * 2 + (wc & 1), __float_as_uint(v)); }
        }
    }
};
struct EpiMerge {
    static constexpr bool PERM = true, AFTER_DRAIN = false;
    const bf16_t* proj; float* T; bf16_t* merged;
    __device__ __forceinline__ void operator()(const f32x4 (&acc)[2][2][4][2], const Unit& u, int wr, int wc, int fr, int fq) const {
        const bool second = u.pn >= 4; const int pn = second ? u.pn - 4 : u.pn, pm = second ? u.pm - 64 : u.pm;
        const int row0 = pm * BM + wr * 64 + fr, col0 = pn * BM + wc * 32 + 8 * fq; const int goff = second ? 1024 : 0;
#pragma unroll
        for (int ai = 0; ai < 2; ++ai)
#pragma unroll
            for (int m = 0; m < 4; ++m) { const size_t row = (size_t)(row0 + ai * HALF + m * 16);
#pragma unroll
                for (int bj = 0; bj < 2; ++bj) { const int col = col0 + bj * HALF;
                    const u32x4 gw = *(const u32x4*)(proj + (size_t)6 * 512 * M_ROWS + row * 2048 + goff + col);
                    const f32x4 g0 = (f32x4){bf_lo(gw.x), bf_hi(gw.x), bf_lo(gw.y), bf_hi(gw.y)}, g1 = (f32x4){bf_lo(gw.z), bf_hi(gw.z), bf_lo(gw.w), bf_hi(gw.w)};
                    f32x4 v0 = acc[ai][bj][m][0] * g0, v1 = acc[ai][bj][m][1] * g1; bf16_t* mp = merged + row * 1024 + col;
                    if (second) { const u32x4 tw = *(const u32x4*)mp;
                        v0 = v0 + (f32x4){bf_lo(tw.x), bf_hi(tw.x), bf_lo(tw.y), bf_hi(tw.y)}; v1 = v1 + (f32x4){bf_lo(tw.z), bf_hi(tw.z), bf_lo(tw.w), bf_hi(tw.w)}; }
                    u32x4 w; w.x = cvt_pk_bf16(v0[0], v0[1]); w.y = cvt_pk_bf16(v0[2], v0[3]); w.z = cvt_pk_bf16(v1[0], v1[1]); w.w = cvt_pk_bf16(v1[2], v1[3]);
                    *(u32x4*)mp = w; }
                asm volatile("" ::: "memory"); }
    }
};
struct PrevLN { const float* src; const float* stats; const float* g; const float* b; };
struct EpiResid {
    static constexpr bool PERM = false, AFTER_DRAIN = false;
    PrevLN p; float* z; float alpha;
    __device__ __forceinline__ void operator()(const f32x4 (&acc)[2][2][4][2], const Unit& u, int wr, int wc, int fr, int fq) const {
        int row0 = u.pm * BM + wr * 64 + fr, col0 = u.pn * BM + wc * 32 + 4 * fq; asm volatile("" : "+v"(row0), "+v"(col0));
        typedef float f32x2v __attribute__((ext_vector_type(2)));
#pragma unroll
        for (int ai = 0; ai < 2; ++ai)
#pragma unroll
            for (int m = 0; m < 4; ++m) { const int row = row0 + ai * HALF + m * 16; const size_t ro = (size_t)row * 1024 + col0; const f32x2v st = *(const f32x2v*)(p.stats + 2 * row);
#pragma unroll
                for (int bj = 0; bj < 2; ++bj)
#pragma unroll
                    for (int n = 0; n < 2; ++n) { const int c = col0 + bj * HALF + n * 16; const size_t off = ro + bj * HALF + n * 16;
                        const f32x4 sv = *(const f32x4*)(p.src + off), gv = *(const f32x4*)(p.g + c), bv = *(const f32x4*)(p.b + c);
                        const f32x4 hv = (sv - st.x) * st.y * gv + bv; *(f32x4*)(z + off) = hv * alpha + acc[ai][bj][m][n]; }
                asm volatile("" ::: "memory"); }
    }
};
struct EpiSwiglu {
    static constexpr bool PERM = true, AFTER_DRAIN = false;
    bf16_t* O; int ldo; int nper;
    __device__ __forceinline__ void operator()(const f32x4 (&acc)[2][2][4][2], const Unit& u, int wr, int wc, int fr, int fq) const {
        const int pnl = u.pn % nper; const int row0 = u.pm * BM + wr * 64 + fr, col0 = pnl * HALF + wc * 32 + 8 * fq;
#pragma unroll
        for (int ai = 0; ai < 2; ++ai)
#pragma unroll
            for (int m = 0; m < 4; ++m) { const f32x4 g0 = acc[ai][0][m][0], g1 = acc[ai][0][m][1], u0 = acc[ai][1][m][0], u1 = acc[ai][1][m][1]; float r[8];
#pragma unroll
                for (int i = 0; i < 4; ++i) { r[i] = g0[i] * sigm(g0[i]) * u0[i]; r[4 + i] = g1[i] * sigm(g1[i]) * u1[i]; }
                u32x4 w; w.x = cvt_pk_bf16(r[0], r[1]); w.y = cvt_pk_bf16(r[2], r[3]); w.z = cvt_pk_bf16(r[4], r[5]); w.w = cvt_pk_bf16(r[6], r[7]);
                *(u32x4*)(O + (size_t)(row0 + ai * HALF + m * 16) * ldo + col0) = w; }
    }
};
struct EpiSwiglu8 {
    static constexpr bool PERM = true, AFTER_DRAIN = false;
    unsigned char* O; int ldo; int nper; float isc, osc;
    __device__ __forceinline__ void operator()(const f32x4 (&acc)[2][2][4][2], const Unit& u, int wr, int wc, int fr, int fq) const {
        const int pnl = u.pn % nper; const int row0 = u.pm * BM + wr * 64 + fr, col0 = pnl * HALF + wc * 32 + 8 * fq;
#pragma unroll
        for (int ai = 0; ai < 2; ++ai)
#pragma unroll
            for (int m = 0; m < 4; ++m) { const f32x4 g0 = acc[ai][0][m][0] * isc, g1 = acc[ai][0][m][1] * isc, u0 = acc[ai][1][m][0] * isc, u1 = acc[ai][1][m][1] * isc; float r[8];
#pragma unroll
                for (int i = 0; i < 4; ++i) { r[i] = g0[i] * sigm(g0[i]) * u0[i] * osc; r[4 + i] = g1[i] * sigm(g1[i]) * u1[i] * osc; }
                int w0 = 0, w1 = 0; w0 = __builtin_amdgcn_cvt_pk_fp8_f32(r[0], r[1], w0, false); w0 = __builtin_amdgcn_cvt_pk_fp8_f32(r[2], r[3], w0, true);
                w1 = __builtin_amdgcn_cvt_pk_fp8_f32(r[4], r[5], w1, false); w1 = __builtin_amdgcn_cvt_pk_fp8_f32(r[6], r[7], w1, true);
                typedef unsigned u32x2 __attribute__((ext_vector_type(2)));
                *(u32x2*)(O + (size_t)(row0 + ai * HALF + m * 16) * ldo + col0) = (u32x2){(unsigned)w0, (unsigned)w1}; }
    }
};
struct EpiStoreF32 {
    static constexpr bool PERM = false, AFTER_DRAIN = false;
    float* O; int nper; float sc;
    __device__ __forceinline__ void operator()(const f32x4 (&acc)[2][2][4][2], const Unit& u, int wr, int wc, int fr, int fq) const {
        const int pnl = u.pn % nper; const int row0 = u.pm * BM + wr * 64 + fr, col0 = pnl * BM + wc * 32 + 4 * fq;
#pragma unroll
        for (int ai = 0; ai < 2; ++ai)
#pragma unroll
            for (int m = 0; m < 4; ++m) { const size_t ro = (size_t)(row0 + ai * HALF + m * 16) * 1024 + col0;
#pragma unroll
                for (int bj = 0; bj < 2; ++bj)
#pragma unroll
                    for (int n = 0; n < 2; ++n) *(f32x4*)(O + ro + bj * HALF + n * 16) = acc[ai][bj][m][n] * sc; }
    }
};
__device__ __forceinline__ void map_unit(int L, int nM, int nN, Unit& u) {
    const int nwg = nM * nN; int wgid = L; { const int q = nwg / NXCD, r = nwg % NXCD, xcd = wgid % NXCD, off = wgid / NXCD; wgid = (xcd < r ? xcd * (q + 1) : r * (q + 1) + (xcd - r) * q) + off; }
    const int nig = WGM * nN, gid = wgid / nig, fm = gid * WGM, gsz = (nM - fm) < WGM ? (nM - fm) : WGM;
    u.pm = fm + ((wgid % nig) % gsz); u.pn = (wgid % nig) / gsz;
}
__device__ __forceinline__ int main_units(int nwg, int G) { const int full = (nwg / G) * G, r = nwg - full; return (r > 0 && r <= G / 8 && full > 0) ? full : nwg; }
constexpr int TAIL_KS = 7, TAIL_K = 256;
typedef int i32x4 __attribute__((ext_vector_type(4)));
struct TableOrder {
    const i32x4* t; int n, G, c;
    __device__ bool next(int i, Unit& u) const { const int j = i * G + c; if (j >= n) return false; const i32x4 e = t[j]; u.pm = __builtin_amdgcn_readfirstlane(e.x); u.pn = __builtin_amdgcn_readfirstlane(e.y); u.koff = __builtin_amdgcn_readfirstlane(e.z); u.aux = __builtin_amdgcn_readfirstlane(e.w); return true; }
    __device__ __forceinline__ void a_ready(const Unit&) const {}
    __device__ __forceinline__ void done(const Unit&) const {}
};
struct EpiStoreTail {
    static constexpr bool PERM = false, AFTER_DRAIN = false;
    float* part; float sc;
    __device__ __forceinline__ void operator()(const f32x4 (&acc)[2][2][4][2], const Unit& u, int wr, int wc, int fr, int fq) const {
        float* base = part + (size_t)u.aux * 65536;
        int row0 = wr * 64 + fr, col0 = wc * 32 + 4 * fq; asm volatile("" : "+v"(row0), "+v"(col0));
#pragma unroll
        for (int ai = 0; ai < 2; ++ai)
#pragma unroll
            for (int m = 0; m < 4; ++m) { const size_t ro = (size_t)(row0 + ai * HALF + m * 16) * 256 + col0;
#pragma unroll
                for (int bj = 0; bj < 2; ++bj)
#pragma unroll
                    for (int n = 0; n < 2; ++n) *(f32x4*)(base + ro + bj * HALF + n * 16) = acc[ai][bj][m][n] * sc; }
    }
};
struct MergeOrder {
    StaticOrder b;
    __device__ bool next(int i, Unit& u) const { if (!b.next(i >> 1, u)) return false; if (i & 1) { u.pm += 64; u.pn += 4; } return true; }
    __device__ __forceinline__ void a_ready(const Unit&) const {}
    __device__ __forceinline__ void done(const Unit&) const {}
};
struct MoeOrder {
    StaticOrder b; const int* te; int nper;
    __device__ bool next(int i, Unit& u) const { if (!b.next(i, u)) return false; u.pn += __builtin_amdgcn_readfirstlane(te[u.pm]) * nper; return true; }
    __device__ __forceinline__ void a_ready(const Unit&) const {}
    __device__ __forceinline__ void done(const Unit&) const {}
};

typedef int i32x4v __attribute__((ext_vector_type(4)));
typedef int i32x8v __attribute__((ext_vector_type(8)));
template <class Epi, class Sched, bool ALIGN_EPI = false, bool SP2 = false, bool F8 = false>
__device__ __forceinline__ void gemm_phase(PG8_LAS unsigned char* lds, const Gemm g, const Sched& S, const Epi& E, const int wv) {
    const int tid = ::mk_tid(wv); const int wid = wv, lane = tid & 63, wr = wid >> 2, wc = wid & 3, fr = lane & 15, fq = lane >> 4;
    const int K = g.K, nt = K / BK, LD = g.ld ? g.ld : g.K;
    unsigned voffA[2], voffB[2];
#pragma unroll
    for (int i = 0; i < 2; ++i) { int R, C; stage_rc(tid * 16 + i * 8192, R, C); const int Rb = Epi::PERM ? ((R & ~31) + perm32(R & 31)) : R;
        voffA[i] = (unsigned)(R * LD + C) * 2u; voffB[i] = (unsigned)(Rb * LD + C) * 2u; }
    const unsigned kstep = (unsigned)(BK * 2);
    const unsigned hstep = (unsigned)HALF * LD * 2;
    const unsigned tstep = 2 * hstep;
    const unsigned ldsw = (unsigned)wid * 1024u;
    const int aoff = lds_byte(wr * 64 + fr, fq * 8), boff = lds_byte(wc * 32 + fr, fq * 8);
#define PG8_SA(b, h) (((b) * 2 + (h)) * HTB)
#define PG8_SB(b, h) ((4 + (b) * 2 + (h)) * HTB)
    const __amdgpu_buffer_rsrc_t rs_voffA = __builtin_amdgcn_make_buffer_rsrc((void*)g.A, 0, 0x7fffffff, 0x00020000);
    const __amdgpu_buffer_rsrc_t rs_voffB = __builtin_amdgcn_make_buffer_rsrc((void*)g.Bt, 0, 0x7fffffff, 0x00020000);
#define PG8_STAGE(bufoff, gbase, voff) do { _Pragma("unroll") for (int _i = 0; _i < 2; ++_i) \
        __builtin_amdgcn_raw_ptr_buffer_load_lds(rs_##voff, (PG8_LAS unsigned*)(lds + (bufoff) + ldsw + _i * 8192), 16, (int)(voff)[_i], (int)(gbase), 0, 0); } while (0)
#define PG8_LDA(dst, b, h) do { if constexpr (F8) { _Pragma("unroll") for (int m = 0; m < 4; ++m) dst##8[m] = __builtin_shufflevector(*(const PG8_LAS i32x4v*)(lds + PG8_SA(b, h) + aoff + m * 2048), *(const PG8_LAS i32x4v*)(lds + PG8_SA(b, h) + aoff + m * 2048 + 1024), 0, 1, 2, 3, 4, 5, 6, 7); } \
        else { _Pragma("unroll") for (int m = 0; m < 4; ++m) _Pragma("unroll") for (int k = 0; k < 2; ++k) dst[m][k] = *(const PG8_LAS bf16x8*)(lds + PG8_SA(b, h) + aoff + m * 2048 + k * 1024); } } while (0)
#define PG8_LDB(dst, b, h) do { if constexpr (F8) { _Pragma("unroll") for (int n = 0; n < 2; ++n) dst##8[n] = __builtin_shufflevector(*(const PG8_LAS i32x4v*)(lds + PG8_SB(b, h) + boff + n * 2048), *(const PG8_LAS i32x4v*)(lds + PG8_SB(b, h) + boff + n * 2048 + 1024), 0, 1, 2, 3, 4, 5, 6, 7); } \
        else { _Pragma("unroll") for (int n = 0; n < 2; ++n) _Pragma("unroll") for (int k = 0; k < 2; ++k) dst[n][k] = *(const PG8_LAS bf16x8*)(lds + PG8_SB(b, h) + boff + n * 2048 + k * 1024); } } while (0)
#define PG8_MMA(ai, bj, At, Bt) do { __builtin_amdgcn_s_setprio(1); _Pragma("unroll") for (int m = 0; m < 4; ++m) _Pragma("unroll") for (int n = 0; n < 2; ++n) { \
        if constexpr (F8) { acc[ai][bj][m][n] = __builtin_amdgcn_mfma_scale_f32_16x16x128_f8f6f4(Bt##8[n], At##8[m], acc[ai][bj][m][n], 0, 0, 0, 0, 0, 0); } \
        else { _Pragma("unroll") for (int k = 0; k < 2; ++k) acc[ai][bj][m][n] = __builtin_amdgcn_mfma_f32_16x16x32_bf16(Bt[n][k], At[m][k], acc[ai][bj][m][n], 0, 0, 0); } } __builtin_amdgcn_s_setprio(0); } while (0)
#define PG8_WAIT_V(n) asm volatile("s_waitcnt vmcnt(" #n ")" ::: "memory")
#define PG8_WAIT_L(n) asm volatile("s_waitcnt lgkmcnt(" #n ")" ::: "memory")
#define PG8_BAR __builtin_amdgcn_s_barrier()
#define PG8_SCHED __builtin_amdgcn_sched_barrier(0)
    Unit cur, nxt; int ui = 0;
    if (!S.next(0, cur)) return;
    f32x4 acc[2][2][4][2];
#pragma unroll
    for (int a = 0; a < 2; ++a)
#pragma unroll
        for (int b = 0; b < 2; ++b)
#pragma unroll
            for (int m = 0; m < 4; ++m)
#pragma unroll
                for (int n = 0; n < 2; ++n) acc[a][b][m][n] = (f32x4){0.f, 0.f, 0.f, 0.f};
    bf16x8 At[4][2], B0[2][2], B1[2][2];
    i32x8v At8[4], B08[2], B18[2];
    unsigned cA = (unsigned)cur.pm * tstep + (unsigned)cur.koff * 2u, cB = (unsigned)cur.pn * tstep + (unsigned)cur.koff * 2u;
    S.a_ready(cur);
    if constexpr (SP2) {
        PG8_STAGE(PG8_SB(0, 0), cB, voffB); PG8_STAGE(PG8_SB(0, 1), cB + hstep, voffB); PG8_STAGE(PG8_SA(0, 0), cA, voffA); PG8_STAGE(PG8_SA(0, 1), cA + hstep, voffA);
        if (wr == 1) PG8_BAR;
        PG8_WAIT_V(2); PG8_BAR;
        PG8_STAGE(PG8_SB(1, 0), cB + kstep, voffB); PG8_STAGE(PG8_SA(1, 0), cA + kstep, voffA); PG8_STAGE(PG8_SB(1, 1), cB + hstep + kstep, voffB);
        PG8_WAIT_V(6); PG8_BAR;
    } else {
        PG8_STAGE(PG8_SB(0, 0), cB, voffB); PG8_STAGE(PG8_SA(0, 0), cA, voffA); PG8_STAGE(PG8_SB(0, 1), cB + hstep, voffB); PG8_STAGE(PG8_SA(0, 1), cA + hstep, voffA);
        if (wr == 1) PG8_BAR;
        PG8_WAIT_V(4); PG8_BAR;
        PG8_STAGE(PG8_SB(1, 0), cB + kstep, voffB); PG8_STAGE(PG8_SA(1, 0), cA + kstep, voffA); PG8_STAGE(PG8_SB(1, 1), cB + hstep + kstep, voffB);
        PG8_WAIT_V(6); PG8_BAR;
    }
    _Pragma("clang loop unroll(disable)")
    for (;;) {
        const bool has_next = S.next(ui + 1, nxt);
        const unsigned nA = has_next ? (unsigned)nxt.pm * tstep + (unsigned)nxt.koff * 2u : cA, nB = has_next ? (unsigned)nxt.pn * tstep + (unsigned)nxt.koff * 2u : cB;
        _Pragma("clang loop unroll(disable)")
        for (int t = 0; t < nt; t += 2) {
            const bool last = (t == nt - 2);
            const unsigned a1 = cA + (unsigned)(t + 1) * kstep;
            const unsigned a2 = last ? nA : cA + (unsigned)(t + 2) * kstep, b2 = last ? nB : cB + (unsigned)(t + 2) * kstep;
            const unsigned a3 = a2 + kstep, b3 = b2 + kstep;
            if (last && has_next) S.a_ready(nxt);
            if constexpr (SP2) {
            PG8_LDB(B0, 0, 0); PG8_LDB(B1, 0, 1); PG8_SCHED; PG8_LDA(At, 0, 0); PG8_STAGE(PG8_SA(1, 1), a1 + hstep, voffA);
            PG8_WAIT_V(8); PG8_WAIT_L(0); PG8_BAR; PG8_MMA(0, 0, At, B0); PG8_MMA(0, 1, At, B1); PG8_BAR; PG8_SCHED;
            PG8_LDA(At, 0, 1); PG8_STAGE(PG8_SB(0, 0), b2, voffB); PG8_STAGE(PG8_SB(0, 1), b2 + hstep, voffB); PG8_STAGE(PG8_SA(0, 0), a2, voffA);
            PG8_WAIT_V(8); PG8_WAIT_L(0); PG8_BAR; PG8_MMA(1, 0, At, B0); PG8_MMA(1, 1, At, B1); PG8_BAR; PG8_SCHED;
            PG8_LDB(B0, 1, 0); PG8_LDB(B1, 1, 1); PG8_SCHED; PG8_LDA(At, 1, 0); PG8_STAGE(PG8_SA(0, 1), a2 + hstep, voffA);
            PG8_WAIT_V(8); PG8_WAIT_L(0); PG8_BAR; PG8_MMA(0, 0, At, B0); PG8_MMA(0, 1, At, B1); PG8_BAR; PG8_SCHED;
            PG8_LDA(At, 1, 1); PG8_STAGE(PG8_SB(1, 0), b3, voffB); PG8_STAGE(PG8_SB(1, 1), b3 + hstep, voffB); PG8_STAGE(PG8_SA(1, 0), a3, voffA);
            PG8_WAIT_V(8); PG8_WAIT_L(0); PG8_BAR; PG8_MMA(1, 0, At, B0); PG8_MMA(1, 1, At, B1); PG8_BAR; PG8_SCHED;
            } else {
            PG8_LDB(B0, 0, 0); PG8_SCHED; PG8_LDA(At, 0, 0); PG8_STAGE(PG8_SA(1, 1), a1 + hstep, voffA);
            PG8_WAIT_L(8); PG8_BAR; PG8_WAIT_L(0); PG8_MMA(0, 0, At, B0); PG8_BAR; PG8_SCHED;
            PG8_LDB(B1, 0, 1); PG8_STAGE(PG8_SB(0, 0), b2, voffB);
            PG8_BAR; PG8_WAIT_L(0); PG8_MMA(0, 1, At, B1); PG8_BAR;
            PG8_LDA(At, 0, 1); PG8_STAGE(PG8_SA(0, 0), a2, voffA);
            PG8_BAR; PG8_WAIT_L(0); PG8_MMA(1, 0, At, B0); PG8_BAR; PG8_SCHED;
            PG8_STAGE(PG8_SB(0, 1), b2 + hstep, voffB);
            PG8_WAIT_V(6); PG8_BAR; PG8_MMA(1, 1, At, B1); PG8_BAR;
            PG8_LDB(B0, 1, 0); PG8_SCHED; PG8_LDA(At, 1, 0); PG8_STAGE(PG8_SA(0, 1), a2 + hstep, voffA);
            PG8_WAIT_L(8); PG8_BAR; PG8_WAIT_L(0); PG8_MMA(0, 0, At, B0); PG8_BAR; PG8_SCHED;
            PG8_LDB(B1, 1, 1); PG8_STAGE(PG8_SB(1, 0), b3, voffB);
            PG8_BAR; PG8_WAIT_L(0); PG8_MMA(0, 1, At, B1); PG8_BAR;
            PG8_LDA(At, 1, 1); PG8_STAGE(PG8_SA(1, 0), a3, voffA);
            PG8_BAR; PG8_WAIT_L(0); PG8_MMA(1, 0, At, B0); PG8_BAR; PG8_SCHED;
            PG8_STAGE(PG8_SB(1, 1), b3 + hstep, voffB);
            PG8_WAIT_V(6); PG8_BAR; PG8_MMA(1, 1, At, B1); PG8_BAR;
            }
        }
        if constexpr (ALIGN_EPI) { if (wr == 0) PG8_BAR; }
        if constexpr (!Epi::AFTER_DRAIN) { const int t2_ = ::mk_tid(wv); const int l2_ = t2_ & 63;
            E(acc, cur, wr, wc, l2_ & 15, l2_ >> 4); S.done(cur); }
        if (!has_next) break;
#pragma unroll
        for (int a = 0; a < 2; ++a)
#pragma unroll
            for (int b = 0; b < 2; ++b)
#pragma unroll
                for (int m = 0; m < 4; ++m)
#pragma unroll
                    for (int n = 0; n < 2; ++n) acc[a][b][m][n] = (f32x4){0.f, 0.f, 0.f, 0.f};
        cur = nxt; cA = nA; cB = nB; ++ui;
        if constexpr (ALIGN_EPI) { if (wr == 1) PG8_BAR; }
    }
    PG8_WAIT_V(0);
    if constexpr (!ALIGN_EPI) { if (wr == 0) PG8_BAR; }
    PG8_BAR;
    if constexpr (Epi::AFTER_DRAIN) { E.fused(acc, cur, wr, wc, fr, fq, lds, wid, lane); S.done(cur); }
#undef PG8_SA
#undef PG8_SB
#undef PG8_STAGE
#undef PG8_LDA
#undef PG8_LDB
#undef PG8_MMA
#undef PG8_WAIT_V
#undef PG8_WAIT_L
#undef PG8_BAR
#undef PG8_SCHED
}
}
namespace attn_body {
#ifdef NOBIAS
constexpr bool NOBIAS_=true;
#else
constexpr bool NOBIAS_=false;
#endif
using bf16=__hip_bfloat16;
using bf16x8=__attribute__((ext_vector_type(8)))short;
using s16x4=__attribute__((ext_vector_type(4)))short;
using f32x16=__attribute__((ext_vector_type(16)))float;
using u32x4=__attribute__((ext_vector_type(4)))unsigned;
constexpr int SEQ=16384,D=64,PITCH=64,OPITCH=512;
constexpr int NW=8,QBLK=32,QB=QBLK*NW,KVBLK=64,NQB=SEQ/QB;
__device__ __forceinline__ int crow(int r,int hi){return (r&3)+8*(r>>2)+4*hi;}
#define SBAR() __builtin_amdgcn_sched_barrier(0)
__device__ __forceinline__ void cmask(f32x16&p0,f32x16&p1,int jb,int qrel,int hi){
  const float NEG=-INFINITY; int kb=64*jb+4*hi;
  #pragma unroll
  for(int r=0;r<16;++r){int kv=kb+(r&3)+8*(r>>2); if(kv>qrel)p0[r]=NEG; if(kv+32>qrel)p1[r]=NEG;}
}

typedef float f32x4a __attribute__((ext_vector_type(4)));
__device__ __forceinline__ void biasf(f32x16&p0,f32x16&p1,const __attribute__((address_space(3))) float*p){
  #pragma unroll
  for(int j=0;j<4;++j){ const f32x4a a=*(const __attribute__((address_space(3))) f32x4a*)(p+8*j), b=*(const __attribute__((address_space(3))) f32x4a*)(p+32+8*j);
    p0[4*j]+=a[0];p0[4*j+1]+=a[1];p0[4*j+2]+=a[2];p0[4*j+3]+=a[3]; p1[4*j]+=b[0];p1[4*j+1]+=b[1];p1[4*j+2]+=b[2];p1[4*j+3]+=b[3];
    asm volatile("":"+v"(p0),"+v"(p1)); __builtin_amdgcn_sched_barrier(0); }
}
__device__ __forceinline__ void biasd(f32x16&p0,f32x16&p1,const __attribute__((address_space(3))) float*lut,int base){
  #pragma unroll
  for(int r=0;r<16;++r){ const int d0=base-((r&3)+8*(r>>2)); unsigned i0=(unsigned)d0; i0=i0>127u?127u:i0; unsigned i1=(unsigned)(d0-32); i1=i1>127u?127u:i1; p0[r]+=lut[i0]; p1[r]+=lut[i1];
    if((r&3)==3){ asm volatile("":"+v"(p0),"+v"(p1)); __builtin_amdgcn_sched_barrier(0); } }
}
typedef float f32x2a __attribute__((ext_vector_type(2)));
__device__ __forceinline__ void submh(f32x16&p0,f32x16&p1,float mh){ const f32x2a m2={mh,mh};
  #pragma unroll
  for(int r=0;r<16;r+=2){ f32x2a a={p0[r],p0[r+1]}, b={p1[r],p1[r+1]}; a=a-m2; b=b-m2; p0[r]=a[0];p0[r+1]=a[1];p1[r]=b[0];p1[r+1]=b[1]; }
}
constexpr int NSLOT=3, SLOTB=8192;
constexpr int LDS_K=0, LDS_V=NSLOT*SLOTB, LDS_WS=2*NSLOT*SLOTB, LDS_OST=LDS_WS+NW*64*4, LDS_KB=LDS_OST+NW*4096, LDS_CNT=LDS_KB+SEQ*4, LDS_BYTES=LDS_CNT+64;
constexpr float C2=0.125f*1.4426950408889634f;
__device__ __forceinline__ void glds16(const void*gsrc,unsigned lds_dst){unsigned keep;
  asm volatile("s_mov_b32 %0, m0\n\ts_mov_b32 m0, %2\n\ts_nop 0\n\tglobal_load_lds_dwordx4 %1, off\n\ts_mov_b32 m0, %0":"=&s"(keep):"v"(gsrc),"s"(lds_dst):"memory");}
typedef int rsrc4 __attribute__((ext_vector_type(4)));
__device__ __forceinline__ rsrc4 mk_rsrc(const void*p){ const unsigned long long a=(unsigned long long)(uintptr_t)p; rsrc4 r; r.x=(int)(unsigned)a; r.y=(int)((unsigned)(a>>32)&0xffffu); r.z=0x7fffffff; r.w=0x00020000; return r; }
__device__ __forceinline__ void bglds16(rsrc4 rs,unsigned voff,unsigned soff,unsigned lds_dst){unsigned keep;
  asm volatile("s_mov_b32 %0, m0\n\ts_mov_b32 m0, %2\n\ts_nop 0\n\tbuffer_load_dwordx4 %1, %3, %4 offen lds\n\ts_mov_b32 m0, %0":"=&s"(keep):"v"(voff),"s"(lds_dst),"s"(rs),"s"(soff):"memory");}
__device__ __forceinline__ float max3f(float a,float b,float c){float r;asm("v_max3_f32 %0, %1, %2, %3":"=v"(r):"v"(a),"v"(b),"v"(c));return r;}
__device__ __forceinline__ float max2f(float a,float b){float r;asm("v_max_f32_e32 %0, %1, %2":"=v"(r):"v"(a),"v"(b));return r;}
__device__ __forceinline__ float fadd_s(float a,float b){float r;asm("v_add_f32_e32 %0, %1, %2":"=v"(r):"v"(a),"v"(b));return r;}
__device__ __forceinline__ float fsub_s(float a,float b){float r;asm("v_sub_f32_e32 %0, %1, %2":"=v"(r):"v"(a),"v"(b));return r;}
typedef float f32x2_t __attribute__((ext_vector_type(2))); typedef __bf16 bf16x2_t __attribute__((ext_vector_type(2)));
__device__ __forceinline__ unsigned cvtpk_s(float lo,float hi){f32x2_t v={lo,hi};bf16x2_t b=__builtin_convertvector(v,bf16x2_t);return __builtin_bit_cast(unsigned,b);}
#define WAIT_BAR(N) asm volatile("s_waitcnt vmcnt(" #N ") lgkmcnt(0)\n\ts_barrier":::"memory")

__device__ __forceinline__ void qkt(f32x16&p0,f32x16&p1,const char*Kslot,const bf16x8*qr,const f32x16&negm,int r32,int hi){
  const char*kb=Kslot+hi*1024+r32*16;
  #pragma unroll
  for(int d0=0;d0<4;++d0){
    const bf16x8 b0=*reinterpret_cast<const bf16x8*>(kb+d0*2048);
    const bf16x8 b1=*reinterpret_cast<const bf16x8*>(kb+d0*2048+512);
    if(d0==0){p0=__builtin_amdgcn_mfma_f32_32x32x16_bf16(b0,qr[0],negm,0,0,0);p1=__builtin_amdgcn_mfma_f32_32x32x16_bf16(b1,qr[0],negm,0,0,0);}
    else{p0=__builtin_amdgcn_mfma_f32_32x32x16_bf16(b0,qr[d0],p0,0,0,0);p1=__builtin_amdgcn_mfma_f32_32x32x16_bf16(b1,qr[d0],p1,0,0,0);}}
}
typedef __attribute__((address_space(3))) const char* lds_cptr;
typedef short v4i16_t __attribute__((ext_vector_type(4)));
__device__ __forceinline__ void kload8(bf16x8*kf,lds_cptr kp){
  kf[0]=*(const __attribute__((address_space(3))) bf16x8*)(kp);      kf[1]=*(const __attribute__((address_space(3))) bf16x8*)(kp+512);
  kf[2]=*(const __attribute__((address_space(3))) bf16x8*)(kp+2048); kf[3]=*(const __attribute__((address_space(3))) bf16x8*)(kp+2560);
  kf[4]=*(const __attribute__((address_space(3))) bf16x8*)(kp+4096); kf[5]=*(const __attribute__((address_space(3))) bf16x8*)(kp+4608);
  kf[6]=*(const __attribute__((address_space(3))) bf16x8*)(kp+6144); kf[7]=*(const __attribute__((address_space(3))) bf16x8*)(kp+6656);
}
__device__ __forceinline__ void kload2(bf16x8*kf,lds_cptr kp,int j){ kf[2*j]=*(const __attribute__((address_space(3))) bf16x8*)(kp+j*2048); kf[2*j+1]=*(const __attribute__((address_space(3))) bf16x8*)(kp+j*2048+512); }
__device__ __forceinline__ s16x4 vtr(lds_cptr p){ return __builtin_bit_cast(s16x4,__builtin_amdgcn_ds_read_tr16_b64_v4i16((__attribute__((address_space(3))) v4i16_t*)p)); }
__device__ __forceinline__ float rowmax(const f32x16&p0,const f32x16&p1){
  float a=max3f(p0[0],p0[1],p1[0]),b=max3f(p0[2],p0[3],p1[1]);a=max3f(a,p1[2],p1[3]);
  #pragma unroll
  for(int r=4;r<16;r+=4){a=max3f(a,p0[r],p0[r+1]);b=max3f(b,p0[r+2],p0[r+3]);a=max3f(a,p1[r],p1[r+1]);b=max3f(b,p1[r+2],p1[r+3]);}
  const float m=max2f(a,b);
  auto rr=__builtin_amdgcn_permlane32_swap(__float_as_uint(m),__float_as_uint(m),false,false);
  return max2f(__uint_as_float(rr[0]),__uint_as_float(rr[1]));
}
__device__ __forceinline__ void pv(f32x16*o,int vb,bf16x8 pa0,bf16x8 pa1,bf16x8 pa2,bf16x8 pa3){
  #pragma unroll
  for(int d0=0;d0<2;++d0){s16x4 lo[4],hi[4];
    #pragma unroll
    for(int ks=0;ks<4;++ks){
      asm volatile("ds_read_b64_tr_b16 %0,%1 offset:%c2":"=&v"(lo[ks]):"v"(vb),"i"(d0*4096+ks*1024):"memory");
      asm volatile("ds_read_b64_tr_b16 %0,%1 offset:%c2":"=&v"(hi[ks]):"v"(vb),"i"(d0*4096+ks*1024+512):"memory");}
    asm volatile("s_waitcnt lgkmcnt(0)":::"memory");SBAR();
    #define PK(k) (bf16x8){lo[k][0],lo[k][1],lo[k][2],lo[k][3],hi[k][0],hi[k][1],hi[k][2],hi[k][3]}
    o[d0]=__builtin_amdgcn_mfma_f32_32x32x16_bf16(pa0,PK(0),o[d0],0,0,0);
    o[d0]=__builtin_amdgcn_mfma_f32_32x32x16_bf16(pa1,PK(1),o[d0],0,0,0);
    o[d0]=__builtin_amdgcn_mfma_f32_32x32x16_bf16(pa2,PK(2),o[d0],0,0,0);
    o[d0]=__builtin_amdgcn_mfma_f32_32x32x16_bf16(pa3,PK(3),o[d0],0,0,0);
    #undef PK
  }
}

#ifndef ATTN_STORE16
#define ATTN_STORE16(p,v) (*(u32x4*)(p)=(v))
#endif
template<int MODE,int THRL> __device__ __forceinline__ void attn_unit(int qb,const bf16*Q,const bf16*__restrict__ K,const bf16*__restrict__ V,bf16*O,const float*__restrict__ cum,const float*__restrict__ relb,const float thr,char*shm,const int wv){
  const int tid=::mk_tid(wv); const int lane=tid&63,r32=lane&31,hi=lane>>5; const int wid=wv;
  const int q0=qb*QB;
  const bf16*Qw=Q+(long)(q0+wid*QBLK)*PITCH;
  typedef __attribute__((address_space(3))) float* lds_fptr;
  const lds_fptr kb3=(lds_fptr)(__attribute__((address_space(3))) char*)shm+LDS_KB/4;
  if constexpr(MODE==0){ const float cref=cum[q0]; for(int i=tid;i<q0+QB;i+=NW*64)kb3[i]=(cref-cum[i])*1.4426950408889634f; }
  int tskip=0;
  if constexpr(MODE==0){
    asm volatile("s_waitcnt lgkmcnt(0)\n\ts_barrier":::"memory");
    const int ntf=(q0+QB)/KVBLK; const int c=(tid<ntf)?(kb3[64*tid+63]<=-thr?1:0):0;
    const int cnt=__popcll(__ballot(c));
    const __attribute__((address_space(3))) int* cw=(const __attribute__((address_space(3))) int*)((__attribute__((address_space(3))) char*)shm+LDS_CNT);
    if(lane==0)((__attribute__((address_space(3))) int*)cw)[wid]=cnt;
    asm volatile("s_waitcnt lgkmcnt(0)\n\ts_barrier":::"memory");
    tskip=(cw[0]+cw[1]+cw[2]+cw[3])&~1; tskip=__builtin_amdgcn_readfirstlane(tskip);
  }
  else { if(tid<128){ int bk=tid; if(tid>=16){ bk=16+(int)(__logf((float)tid*(1.f/16.f))/2.0794415416798357f*16.f); bk=bk>31?31:bk; } kb3[tid]=(relb[bk*4]-relb[31*4])*1.4426950408889634f; } }
  const unsigned lds0=(unsigned)(uintptr_t)shm;
  float*wsf=(float*)(shm+LDS_WS)+wid*64;
  const bf16*Kh=K+(long)tskip*KVBLK*PITCH,*Vh=V+(long)tskip*KVBLK*PITCH; const lds_fptr kbt=kb3+64*tskip;
  const bf16*ksrc=Kh+(long)lane*PITCH+wid*8;
  const bf16*vsrc=Vh+(long)(16*(wid&3)+(lane>>2))*PITCH+(wid>>2)*32+(lane&3)*8;
  const unsigned kdst=lds0+LDS_K+wid*1024, vdst=lds0+LDS_V+wid*1024;
  #define DMA_K(t,slot) glds16(ksrc+(long)(t)*KVBLK*PITCH,(unsigned)__builtin_amdgcn_readfirstlane(kdst+(slot)))
  #define DMA_V(t,slot) glds16(vsrc+(long)(t)*KVBLK*PITCH,(unsigned)__builtin_amdgcn_readfirstlane(vdst+(slot)))
  const int vb0=(int)(lds0+LDS_V)+((lane>>4)&1)*32+(lane&3)*8+(4*hi+((lane&15)>>2))*64;
  const char*Kbase=shm+LDS_K; bf16x8 kf[8];
  const lds_cptr shm3=(lds_cptr)shm; const lds_cptr kp0=shm3+LDS_K+hi*1024+r32*16; const lds_cptr vp0=shm3+LDS_V+((lane>>4)&1)*32+(lane&3)*8+(4*hi+((lane&15)>>2))*64;
  const int NT=(q0+QB)/KVBLK-tskip;
  DMA_K(0,0);DMA_V(0,0);DMA_K(1,SLOTB);
  bf16x8 qr[4];
  #pragma unroll
  for(int d0=0;d0<4;++d0)qr[d0]=*reinterpret_cast<const bf16x8*>(&Qw[(long)r32*PITCH+d0*16+hi*8]);
  float mhat=0.f,l_reg=0.f;f32x16 o[2];o[0]=f32x16{};o[1]=f32x16{};const f32x16 z16=f32x16{};
  const int qrel=wid*QBLK+r32;
  #define CMASK(P0,P1,t) do{int jb_=(t)-(NT-4); if(jb_>=0)cmask(P0,P1,jb_,qrel,hi);}while(0)
  #define BIAS(P0,P1,t) do{ if constexpr(NOBIAS_) {} else if constexpr(MODE==0){ biasf(P0,P1,kbt+(64*(t)+4*hi)); } else { biasd(P0,P1,kb3,qrel-64*((t)-(NT-4))-4*hi); } }while(0)
  bool resc=false;
  #define START(P0,P1) do{ const float rm=rowmax(P0,P1); resc=false; \
    { const float dl=rm; mhat=fadd_s(mhat,dl); \
      _Pragma("unroll") for(int r=0;r<16;++r){P0[r]=fsub_s(P0[r],dl);P1[r]=fsub_s(P1[r],dl);} \
      } \
    _Pragma("unroll") for(int r=0;r<16;++r)P0[r]=__builtin_amdgcn_exp2f(P0[r]); }while(0)
  #define RESC() do{ if(resc){ asm volatile("s_waitcnt lgkmcnt(0)":::"memory"); \
      _Pragma("unroll") for(int d_=0;d_<2;++d_) _Pragma("unroll") for(int r=0;r<16;++r)o[d_][r]*=wsf[crow(r,hi)]; } }while(0)
  f32x16 pA0,pA1,pB0,pB1;
  int sl_prev=0,sl_cur=0,sl_next=SLOTB;
  #define ROT() do{sl_prev=sl_cur;sl_cur=sl_next;sl_next=(sl_next==(NSLOT-1)*SLOTB)?0:sl_next+SLOTB;}while(0)
  DMA_K(2,2*SLOTB);
  WAIT_BAR(3);
  qkt(pA0,pA1,Kbase,qr,z16,r32,hi);asm volatile("s_nop 15\n\ts_nop 7":"+v"(pA0),"+v"(pA1));BIAS(pA0,pA1,0);CMASK(pA0,pA1,0);
  START(pA0,pA1);
  _Pragma("unroll") for(int r=0;r<16;++r)pA1[r]=__builtin_amdgcn_exp2f(pA1[r]);
  WAIT_BAR(0);
  DMA_K(3,0);DMA_V(1,SLOTB);
  ROT();
  kload8(kf,kp0+sl_cur);
  WAIT_BAR(2);
  s16x4 vlo[8],vhi[8]; u32x4 pw0,pw1,pw2,pw3;
  #define PKW(P,B) cvtpk_s(P[B],P[B+1])
  #define PAF(k) __builtin_bit_cast(bf16x8,pw##k)
  #define VFR(i) (bf16x8){vlo[i][0],vlo[i][1],vlo[i][2],vlo[i][3],vhi[i][0],vhi[i][1],vhi[i][2],vhi[i][3]}
  #define PIN(x) asm volatile("":"+v"(x))
  #define MX3(a,b,c) __builtin_fmaxf(__builtin_fmaxf((a),(b)),(c))
  #define GAPA(MF,A0,A1,A2,A3,W0,W1,PW) do{ MF; sacc+=A0; sacc+=A1; sacc+=A2; sacc+=A3; PIN(sacc); W0; W1; PIN(PW); SBAR(); }while(0)
  #define EX(v) __builtin_amdgcn_exp2f(v)
  #define GAPB(MF,X,B) do{ MF; X[B]=EX(X[B]); X[B+1]=EX(X[B+1]); X[B+2]=EX(X[B+2]); X[B+3]=EX(X[B+3]); PIN(X); SBAR(); }while(0)
  #define VRD(i) do{ vlo[i]=vtr(vp_+(((i)>>2)*4096+((i)&3)*1024)); vhi[i]=vtr(vp_+(((i)>>2)*4096+((i)&3)*1024+512)); }while(0)
  #define KRD(G,j) do{ if(G){ kload2(kf,kp0+sl_next,j); SBAR(); } }while(0)
  #define STEP(C0,C1,P0,P1,t,GK,GV,GL) do{ SBAR(); \
    const lds_cptr vp_=vp0+sl_prev; \
    VRD(0); SBAR(); float sacc=(P0[0]+P0[1]); \
    GAPA(C0=__builtin_amdgcn_mfma_f32_32x32x16_bf16(kf[0],qr[0],z16,0,0,0), P0[2],P0[3],P0[4],P0[5],     pw0[0]=PKW(P0,0), pw0[1]=PKW(P0,2), pw0); \
    VRD(4); SBAR(); GAPA(C1=__builtin_amdgcn_mfma_f32_32x32x16_bf16(kf[1],qr[0],z16,0,0,0), P0[6],P0[7],P0[8],P0[9],     pw0[2]=PKW(P0,4), pw0[3]=PKW(P0,6), pw0); \
    VRD(1); SBAR(); GAPA(C0=__builtin_amdgcn_mfma_f32_32x32x16_bf16(kf[2],qr[1],C0,0,0,0),   P0[10],P0[11],P0[12],P0[13], pw1[0]=PKW(P0,8), pw1[1]=PKW(P0,10), pw1); \
    VRD(5); SBAR(); GAPA(C1=__builtin_amdgcn_mfma_f32_32x32x16_bf16(kf[3],qr[1],C1,0,0,0),   P0[14],P0[15],P1[0],P1[1],   pw1[2]=PKW(P0,12),pw1[3]=PKW(P0,14), pw1); \
    VRD(2); SBAR(); GAPA(C0=__builtin_amdgcn_mfma_f32_32x32x16_bf16(kf[4],qr[2],C0,0,0,0),   P1[2],P1[3],P1[4],P1[5],     pw2[0]=PKW(P1,0), pw2[1]=PKW(P1,2), pw2); \
    VRD(6); SBAR(); GAPA(C1=__builtin_amdgcn_mfma_f32_32x32x16_bf16(kf[5],qr[2],C1,0,0,0),   P1[6],P1[7],P1[8],P1[9],     pw2[2]=PKW(P1,4), pw2[3]=PKW(P1,6), pw2); \
    VRD(3); SBAR(); GAPA(C0=__builtin_amdgcn_mfma_f32_32x32x16_bf16(kf[6],qr[3],C0,0,0,0),   P1[10],P1[11],P1[12],P1[13], pw3[0]=PKW(P1,8), pw3[1]=PKW(P1,10), pw3); \
    VRD(7); SBAR(); GAPA(C1=__builtin_amdgcn_mfma_f32_32x32x16_bf16(kf[7],qr[3],C1,0,0,0),   P1[14],P1[15],0.f,0.f,       pw3[2]=PKW(P1,12),pw3[3]=PKW(P1,14), pw3); \
    l_reg+=sacc; \
    if(GK){DMA_K((t)+3,sl_cur);} if(GV){DMA_V((t)+1,sl_next);} \
    BIAS(C0,C1,t); CMASK(C0,C1,t); submh(C0,C1,mhat); \
    { float a=MX3(C0[0],C0[1],C1[0]),b=MX3(C0[2],C0[3],C1[1]); a=MX3(a,C1[2],C1[3]); \
      _Pragma("unroll") for(int r=4;r<16;r+=4){a=MX3(a,C0[r],C0[r+1]);b=MX3(b,C0[r+2],C0[r+3]);a=MX3(a,C1[r],C1[r+1]);b=MX3(b,C1[r+2],C1[r+3]);} \
      float rm=__builtin_fmaxf(a,b); { auto rr=__builtin_amdgcn_permlane32_swap(__float_as_uint(rm),__float_as_uint(rm),false,false); rm=__builtin_fmaxf(__uint_as_float(rr[0]),__uint_as_float(rr[1])); } \
      resc=false; \
      if(__builtin_expect(__any(rm>(float)THRL),0)){ const float dl=__builtin_fmaxf(rm,0.f); mhat+=dl; \
        _Pragma("unroll") for(int r=0;r<16;++r){C0[r]-=dl;C1[r]-=dl;} \
        const float f=__builtin_amdgcn_exp2f(-dl); l_reg*=f; if(hi==0)wsf[r32]=f; resc=true; } } \
    SBAR(); \
    GAPB(o[0]=__builtin_amdgcn_mfma_f32_32x32x16_bf16(PAF(0),VFR(0),o[0],0,0,0), C0,0); \
    GAPB(o[1]=__builtin_amdgcn_mfma_f32_32x32x16_bf16(PAF(0),VFR(4),o[1],0,0,0), C0,4); \
    KRD(GL,0); GAPB(o[0]=__builtin_amdgcn_mfma_f32_32x32x16_bf16(PAF(1),VFR(1),o[0],0,0,0), C0,8); \
    KRD(GL,1); GAPB(o[1]=__builtin_amdgcn_mfma_f32_32x32x16_bf16(PAF(1),VFR(5),o[1],0,0,0), C0,12); \
    KRD(GL,2); GAPB(o[0]=__builtin_amdgcn_mfma_f32_32x32x16_bf16(PAF(2),VFR(2),o[0],0,0,0), C1,0); \
    KRD(GL,3); GAPB(o[1]=__builtin_amdgcn_mfma_f32_32x32x16_bf16(PAF(2),VFR(6),o[1],0,0,0), C1,4); \
    GAPB(o[0]=__builtin_amdgcn_mfma_f32_32x32x16_bf16(PAF(3),VFR(3),o[0],0,0,0), C1,8); \
    GAPB(o[1]=__builtin_amdgcn_mfma_f32_32x32x16_bf16(PAF(3),VFR(7),o[1],0,0,0), C1,12); \
    }while(0)
  int t=1;
  #undef CMASK
  #define CMASK(P0,P1,t) do{}while(0)
  #undef BIAS
  #define BIAS(P0,P1,t) do{ if constexpr(NOBIAS_) {} else if constexpr(MODE==0){ biasf(P0,P1,kbt+(64*(t)+4*hi)); } }while(0)
  constexpr int NEAR=(MODE==1)?7:5;
  for(;t+NEAR<NT;t+=2){
    STEP(pB0,pB1,pA0,pA1,t,true,true,true);     WAIT_BAR(2); RESC(); ROT();
    STEP(pA0,pA1,pB0,pB1,t+1,true,true,true);   WAIT_BAR(2); RESC(); ROT();
  }
  #undef CMASK
  #define CMASK(P0,P1,t) do{int jb_=(t)-(NT-4); if(jb_>=0)cmask(P0,P1,jb_,qrel,hi);}while(0)
  #undef BIAS
  #define BIAS(P0,P1,t) do{ if constexpr(NOBIAS_) {} else if constexpr(MODE==0){ biasf(P0,P1,kbt+(64*(t)+4*hi)); } else { biasd(P0,P1,kb3,qrel-64*((t)-(NT-4))-4*hi); } }while(0)
  #define ENDW(tt) do{ if((tt)+3<NT){WAIT_BAR(2);} else if((tt)+2<NT){WAIT_BAR(1);} else {WAIT_BAR(0);} }while(0)
  for(;t+1<NT;t+=2){
    STEP(pB0,pB1,pA0,pA1,t,(t+3<NT),(t+1<NT),(t+1<NT));       ENDW(t);   RESC(); ROT();
    STEP(pA0,pA1,pB0,pB1,t+1,(t+4<NT),(t+2<NT),(t+2<NT));     ENDW(t+1); RESC(); ROT();
  }
  STEP(pB0,pB1,pA0,pA1,NT-1,false,false,false); RESC();
  { float sacc=pB0[0]+pB0[1]; _Pragma("unroll") for(int r=2;r<16;++r)sacc+=pB0[r]; _Pragma("unroll") for(int r=0;r<16;++r)sacc+=pB1[r]; l_reg+=sacc;
    pw0=(u32x4){PKW(pB0,0),PKW(pB0,2),PKW(pB0,4),PKW(pB0,6)};pw1=(u32x4){PKW(pB0,8),PKW(pB0,10),PKW(pB0,12),PKW(pB0,14)};pw2=(u32x4){PKW(pB1,0),PKW(pB1,2),PKW(pB1,4),PKW(pB1,6)};pw3=(u32x4){PKW(pB1,8),PKW(pB1,10),PKW(pB1,12),PKW(pB1,14)};
    SBAR(); pv(o,vb0+sl_cur,PAF(0),PAF(1),PAF(2),PAF(3)); }
  #undef PKW
  #undef PAF
  #undef VFR
  #undef PIN
  #undef MX3
  #undef GAPA
  #undef GAPB
  #undef EX
  #undef VRD
  #undef KRD
  #undef STEP
  #undef ENDW
  {auto rr=__builtin_amdgcn_permlane32_swap(__float_as_uint(l_reg),__float_as_uint(l_reg),false,false);l_reg=__uint_as_float(rr[0])+__uint_as_float(rr[1]);}
  if(hi==0)wsf[32+r32]=l_reg;asm volatile("s_waitcnt lgkmcnt(0)":::"memory");
  float rli[16];
  #pragma unroll
  for(int r=0;r<16;++r)rli[r]=__builtin_amdgcn_rcpf(wsf[32+crow(r,hi)]);
  bf16*Ow=O+(long)(q0+wid*QBLK)*OPITCH;
  { bf16*stg=(bf16*)(shm+LDS_OST)+wid*2048;
    #pragma unroll
    for(int r=0;r<16;++r){const int orow=crow(r,hi);
      #pragma unroll
      for(int d0=0;d0<2;++d0)stg[orow*64+d0*32+r32]=__float2bfloat16(o[d0][r]*rli[r]);}
    asm volatile("s_waitcnt lgkmcnt(0)":::"memory");
    #pragma unroll
    for(int i=0;i<4;++i){const int row=i*8+(lane>>3),ch=lane&7; const u32x4 v=*(const u32x4*)(stg+row*64+ch*8); ATTN_STORE16(Ow+(long)row*OPITCH+ch*8,v);} }
  asm volatile("s_waitcnt lgkmcnt(0)\n\ts_barrier":::"memory");
  #undef DMA_K
  #undef DMA_V
  #undef CMASK
  #undef BIAS
  #undef START
  #undef RESC
  #undef ROT
}
template<int THRL> __device__ __forceinline__ void attn_unit_d(int qb,const bf16*Q,const bf16*__restrict__ K,const bf16*__restrict__ V,bf16*O,const float*__restrict__ cum,const float*__restrict__ relb,const float thr,char*shm,const int wv){
  const int tid=::mk_tid(wv); const int lane=tid&63,r32=lane&31,hi=lane>>5; const int wid=wv;
  constexpr int MODE=1; constexpr int VSLOT=16384; constexpr int LDS_WS=LDS_V+NSLOT*VSLOT, LDS_OST=LDS_WS+NW*64*4, LDS_KB=LDS_OST+NW*4096; static_assert(LDS_KB+512<=LDS_BYTES,"lds");
  const int q0=qb*QB;
  const bf16*Qw=Q+(long)(q0+wid*QBLK)*PITCH;
  typedef __attribute__((address_space(3))) float* lds_fptr;
  const lds_fptr kb3=(lds_fptr)(__attribute__((address_space(3))) char*)shm+LDS_KB/4;
  if constexpr(MODE==0){ const float cref=cum[q0]; for(int i=tid;i<q0+QB;i+=NW*64)kb3[i]=(cref-cum[i])*1.4426950408889634f; }
  int tskip=0;
  if constexpr(MODE==0){
    asm volatile("s_waitcnt lgkmcnt(0)\n\ts_barrier":::"memory");
    const int ntf=(q0+QB)/KVBLK; const int c=(tid<ntf)?(kb3[64*tid+63]<=-thr?1:0):0;
    const int cnt=__popcll(__ballot(c));
    const __attribute__((address_space(3))) int* cw=(const __attribute__((address_space(3))) int*)((__attribute__((address_space(3))) char*)shm+LDS_CNT);
    if(lane==0)((__attribute__((address_space(3))) int*)cw)[wid]=cnt;
    asm volatile("s_waitcnt lgkmcnt(0)\n\ts_barrier":::"memory");
    tskip=(cw[0]+cw[1]+cw[2]+cw[3])&~1; tskip=__builtin_amdgcn_readfirstlane(tskip);
  }
  else { if(tid<128){ int bk=tid; if(tid>=16){ bk=16+(int)(__logf((float)tid*(1.f/16.f))/2.0794415416798357f*16.f); bk=bk>31?31:bk; } kb3[tid]=(relb[bk*4]-relb[31*4])*1.4426950408889634f; } }
  const unsigned lds0=(unsigned)(uintptr_t)shm;
  float*wsf=(float*)(shm+LDS_WS)+wid*64;
  const bf16*Kh=K+(long)tskip*KVBLK*PITCH,*Vh=V+(long)tskip*KVBLK*PITCH; const lds_fptr kbt=kb3+64*tskip;
  const rsrc4 rK=mk_rsrc(Kh), rV=mk_rsrc(Vh); const unsigned kvo=(unsigned)(lane*PITCH+wid*8)*2u;
  constexpr int VPITCH=128;
  const unsigned vvo=(unsigned)((16*(wid&3)+(lane>>2))*VPITCH+(wid>>2)*32+(lane&3)*8)*2u;
  const unsigned kdst=lds0+LDS_K+wid*1024, vdst=lds0+LDS_V+wid*1024;
  #define DMA_K(t,slot) bglds16(rK,kvo,(unsigned)__builtin_amdgcn_readfirstlane((t)*(KVBLK*PITCH*2)),(unsigned)__builtin_amdgcn_readfirstlane(kdst+(slot)))
  #define DMA_V(t,slot) do{ bglds16(rV,vvo,(unsigned)__builtin_amdgcn_readfirstlane((t)*(KVBLK*VPITCH*2)),(unsigned)__builtin_amdgcn_readfirstlane(vdst+(slot))); bglds16(rV,vvo,(unsigned)__builtin_amdgcn_readfirstlane((t)*(KVBLK*VPITCH*2)+128),(unsigned)__builtin_amdgcn_readfirstlane(vdst+8192+(slot))); }while(0)
  const int vb0=(int)(lds0+LDS_V)+((lane>>4)&1)*32+(lane&3)*8+(4*hi+((lane&15)>>2))*64;
  const char*Kbase=shm+LDS_K; bf16x8 kf[8];
  const lds_cptr shm3=(lds_cptr)shm; const lds_cptr kp0=shm3+LDS_K+hi*1024+r32*16; const lds_cptr vp0=shm3+LDS_V+((lane>>4)&1)*32+(lane&3)*8+(4*hi+((lane&15)>>2))*64;
  const int NT=(q0+QB)/KVBLK-tskip;
  DMA_K(0,0);DMA_V(0,0);DMA_K(1,SLOTB);
  bf16x8 qr[4];
  #pragma unroll
  for(int d0=0;d0<4;++d0)qr[d0]=*reinterpret_cast<const bf16x8*>(&Qw[(long)r32*PITCH+d0*16+hi*8]);
  float mhat=0.f,l_reg=0.f;f32x16 o[4];o[0]=f32x16{};o[1]=f32x16{};o[2]=f32x16{};o[3]=f32x16{};const f32x16 z16=f32x16{};
  const int qrel=wid*QBLK+r32;
  #define CMASK(P0,P1,t) do{int jb_=(t)-(NT-4); if(jb_>=0)cmask(P0,P1,jb_,qrel,hi);}while(0)
  #define BIAS(P0,P1,t) do{ if constexpr(NOBIAS_) {} else if constexpr(MODE==0){ biasf(P0,P1,kbt+(64*(t)+4*hi)); } else { biasd(P0,P1,kb3,qrel-64*((t)-(NT-4))-4*hi); } }while(0)
  bool resc=false;
  #define START(P0,P1) do{ const float rm=rowmax(P0,P1); resc=false; \
    { const float dl=rm; mhat=fadd_s(mhat,dl); \
      _Pragma("unroll") for(int r=0;r<16;++r){P0[r]=fsub_s(P0[r],dl);P1[r]=fsub_s(P1[r],dl);} \
      } \
    _Pragma("unroll") for(int r=0;r<16;++r)P0[r]=__builtin_amdgcn_exp2f(P0[r]); }while(0)
  #define RESC() do{ if(resc){ asm volatile("s_waitcnt lgkmcnt(0)":::"memory"); \
      _Pragma("unroll") for(int d_=0;d_<4;++d_) _Pragma("unroll") for(int r=0;r<16;++r)o[d_][r]*=wsf[crow(r,hi)]; } }while(0)
  f32x16 pA0,pA1,pB0,pB1;
  int sl_prev=0,sl_cur=0,sl_next=SLOTB;
  #define ROT() do{sl_prev=sl_cur;sl_cur=sl_next;sl_next=(sl_next==(NSLOT-1)*SLOTB)?0:sl_next+SLOTB;}while(0)
  DMA_K(2,2*SLOTB);
  WAIT_BAR(4);
  qkt(pA0,pA1,Kbase,qr,z16,r32,hi);asm volatile("s_nop 15\n\ts_nop 7":"+v"(pA0),"+v"(pA1));BIAS(pA0,pA1,0);CMASK(pA0,pA1,0);
  START(pA0,pA1);
  _Pragma("unroll") for(int r=0;r<16;++r)pA1[r]=__builtin_amdgcn_exp2f(pA1[r]);
  WAIT_BAR(0);
  DMA_K(3,0);DMA_V(1,VSLOT);
  ROT();
  kload8(kf,kp0+sl_cur);
  WAIT_BAR(3);
  s16x4 vlo[8],vhi[8]; u32x4 pw0,pw1,pw2,pw3;
  #define PKW(P,B) cvtpk_s(P[B],P[B+1])
  #define PAF(k) __builtin_bit_cast(bf16x8,pw##k)
  #define VFR(i) (bf16x8){vlo[i][0],vlo[i][1],vlo[i][2],vlo[i][3],vhi[i][0],vhi[i][1],vhi[i][2],vhi[i][3]}
  #define PIN(x) asm volatile("":"+v"(x))
  #define MX3(a,b,c) __builtin_fmaxf(__builtin_fmaxf((a),(b)),(c))
  #define GAPA(MF,A0,A1,A2,A3,W0,W1,PW) do{ MF; sacc+=A0; sacc+=A1; sacc+=A2; sacc+=A3; PIN(sacc); W0; W1; PIN(PW); SBAR(); }while(0)
  #define EX(v) __builtin_amdgcn_exp2f(v)
  #define GAPB(MF,X,B) do{ MF; X[B]=EX(X[B]); X[B+1]=EX(X[B+1]); PIN(X); SBAR(); }while(0)
  #define VRD2(i) do{ vlo[i]=vtr(vp_+(8192+((i)>>2)*4096+((i)&3)*1024)); vhi[i]=vtr(vp_+(8192+((i)>>2)*4096+((i)&3)*1024+512)); }while(0)
  #define VRD(i) do{ vlo[i]=vtr(vp_+(((i)>>2)*4096+((i)&3)*1024)); vhi[i]=vtr(vp_+(((i)>>2)*4096+((i)&3)*1024+512)); }while(0)
  #define KRD(G,j) do{ if(G){ kload2(kf,kp0+sl_next,j); SBAR(); } }while(0)
  #define STEP(C0,C1,P0,P1,t,GK,GV,GL) do{ SBAR(); \
    const lds_cptr vp_=vp0+2*sl_prev; \
    VRD(0); SBAR(); float sacc=(P0[0]+P0[1]); \
    GAPA(C0=__builtin_amdgcn_mfma_f32_32x32x16_bf16(kf[0],qr[0],z16,0,0,0), P0[2],P0[3],P0[4],P0[5],     pw0[0]=PKW(P0,0), pw0[1]=PKW(P0,2), pw0); \
    VRD(4); SBAR(); GAPA(C1=__builtin_amdgcn_mfma_f32_32x32x16_bf16(kf[1],qr[0],z16,0,0,0), P0[6],P0[7],P0[8],P0[9],     pw0[2]=PKW(P0,4), pw0[3]=PKW(P0,6), pw0); \
    VRD(1); SBAR(); GAPA(C0=__builtin_amdgcn_mfma_f32_32x32x16_bf16(kf[2],qr[1],C0,0,0,0),   P0[10],P0[11],P0[12],P0[13], pw1[0]=PKW(P0,8), pw1[1]=PKW(P0,10), pw1); \
    VRD(5); SBAR(); GAPA(C1=__builtin_amdgcn_mfma_f32_32x32x16_bf16(kf[3],qr[1],C1,0,0,0),   P0[14],P0[15],P1[0],P1[1],   pw1[2]=PKW(P0,12),pw1[3]=PKW(P0,14), pw1); \
    VRD(2); SBAR(); GAPA(C0=__builtin_amdgcn_mfma_f32_32x32x16_bf16(kf[4],qr[2],C0,0,0,0),   P1[2],P1[3],P1[4],P1[5],     pw2[0]=PKW(P1,0), pw2[1]=PKW(P1,2), pw2); \
    VRD(6); SBAR(); GAPA(C1=__builtin_amdgcn_mfma_f32_32x32x16_bf16(kf[5],qr[2],C1,0,0,0),   P1[6],P1[7],P1[8],P1[9],     pw2[2]=PKW(P1,4), pw2[3]=PKW(P1,6), pw2); \
    VRD(3); SBAR(); GAPA(C0=__builtin_amdgcn_mfma_f32_32x32x16_bf16(kf[6],qr[3],C0,0,0,0),   P1[10],P1[11],P1[12],P1[13], pw3[0]=PKW(P1,8), pw3[1]=PKW(P1,10), pw3); \
    VRD(7); SBAR(); GAPA(C1=__builtin_amdgcn_mfma_f32_32x32x16_bf16(kf[7],qr[3],C1,0,0,0),   P1[14],P1[15],0.f,0.f,       pw3[2]=PKW(P1,12),pw3[3]=PKW(P1,14), pw3); \
    l_reg+=sacc; \
    if(GK){DMA_K((t)+3,sl_cur);} if(GV){DMA_V((t)+1,2*sl_next);} \
    BIAS(C0,C1,t); CMASK(C0,C1,t); submh(C0,C1,mhat); \
    { float a=MX3(C0[0],C0[1],C1[0]),b=MX3(C0[2],C0[3],C1[1]); a=MX3(a,C1[2],C1[3]); \
      _Pragma("unroll") for(int r=4;r<16;r+=4){a=MX3(a,C0[r],C0[r+1]);b=MX3(b,C0[r+2],C0[r+3]);a=MX3(a,C1[r],C1[r+1]);b=MX3(b,C1[r+2],C1[r+3]);} \
      float rm=__builtin_fmaxf(a,b); { auto rr=__builtin_amdgcn_permlane32_swap(__float_as_uint(rm),__float_as_uint(rm),false,false); rm=__builtin_fmaxf(__uint_as_float(rr[0]),__uint_as_float(rr[1])); } \
      resc=false; \
      if(__builtin_expect(__any(rm>(float)THRL),0)){ const float dl=__builtin_fmaxf(rm,0.f); mhat+=dl; \
        _Pragma("unroll") for(int r=0;r<16;++r){C0[r]-=dl;C1[r]-=dl;} \
        const float f=__builtin_amdgcn_exp2f(-dl); l_reg*=f; if(hi==0)wsf[r32]=f; resc=true; } } \
    SBAR(); \
    GAPB(o[0]=__builtin_amdgcn_mfma_f32_32x32x16_bf16(PAF(0),VFR(0),o[0],0,0,0), C0,0);  VRD2(0); SBAR(); \
    GAPB(o[1]=__builtin_amdgcn_mfma_f32_32x32x16_bf16(PAF(0),VFR(4),o[1],0,0,0), C0,2);  VRD2(4); SBAR(); \
    KRD(GL,0); GAPB(o[0]=__builtin_amdgcn_mfma_f32_32x32x16_bf16(PAF(1),VFR(1),o[0],0,0,0), C0,4);  VRD2(1); SBAR(); \
    KRD(GL,1); GAPB(o[1]=__builtin_amdgcn_mfma_f32_32x32x16_bf16(PAF(1),VFR(5),o[1],0,0,0), C0,6);  VRD2(5); SBAR(); \
    KRD(GL,2); GAPB(o[0]=__builtin_amdgcn_mfma_f32_32x32x16_bf16(PAF(2),VFR(2),o[0],0,0,0), C0,8);  VRD2(2); SBAR(); \
    KRD(GL,3); GAPB(o[1]=__builtin_amdgcn_mfma_f32_32x32x16_bf16(PAF(2),VFR(6),o[1],0,0,0), C0,10); VRD2(6); SBAR(); \
    GAPB(o[0]=__builtin_amdgcn_mfma_f32_32x32x16_bf16(PAF(3),VFR(3),o[0],0,0,0), C0,12); VRD2(3); SBAR(); \
    GAPB(o[1]=__builtin_amdgcn_mfma_f32_32x32x16_bf16(PAF(3),VFR(7),o[1],0,0,0), C0,14); VRD2(7); SBAR(); \
    GAPB(o[2]=__builtin_amdgcn_mfma_f32_32x32x16_bf16(PAF(0),VFR(0),o[2],0,0,0), C1,0); \
    GAPB(o[3]=__builtin_amdgcn_mfma_f32_32x32x16_bf16(PAF(0),VFR(4),o[3],0,0,0), C1,2); \
    GAPB(o[2]=__builtin_amdgcn_mfma_f32_32x32x16_bf16(PAF(1),VFR(1),o[2],0,0,0), C1,4); \
    GAPB(o[3]=__builtin_amdgcn_mfma_f32_32x32x16_bf16(PAF(1),VFR(5),o[3],0,0,0), C1,6); \
    GAPB(o[2]=__builtin_amdgcn_mfma_f32_32x32x16_bf16(PAF(2),VFR(2),o[2],0,0,0), C1,8); \
    GAPB(o[3]=__builtin_amdgcn_mfma_f32_32x32x16_bf16(PAF(2),VFR(6),o[3],0,0,0), C1,10); \
    GAPB(o[2]=__builtin_amdgcn_mfma_f32_32x32x16_bf16(PAF(3),VFR(3),o[2],0,0,0), C1,12); \
    GAPB(o[3]=__builtin_amdgcn_mfma_f32_32x32x16_bf16(PAF(3),VFR(7),o[3],0,0,0), C1,14); \
    }while(0)
  int t=1;
  #undef CMASK
  #define CMASK(P0,P1,t) do{}while(0)
  #undef BIAS
  #define BIAS(P0,P1,t) do{ if constexpr(NOBIAS_) {} else if constexpr(MODE==0){ biasf(P0,P1,kbt+(64*(t)+4*hi)); } }while(0)
  constexpr int NEAR=(MODE==1)?7:5;
  for(;t+NEAR<NT;t+=2){
    STEP(pB0,pB1,pA0,pA1,t,true,true,true);     WAIT_BAR(3); RESC(); ROT();
    STEP(pA0,pA1,pB0,pB1,t+1,true,true,true);   WAIT_BAR(3); RESC(); ROT();
  }
  #undef CMASK
  #define CMASK(P0,P1,t) do{int jb_=(t)-(NT-4); if(jb_>=0)cmask(P0,P1,jb_,qrel,hi);}while(0)
  #undef BIAS
  #define BIAS(P0,P1,t) do{ if constexpr(NOBIAS_) {} else if constexpr(MODE==0){ biasf(P0,P1,kbt+(64*(t)+4*hi)); } else { biasd(P0,P1,kb3,qrel-64*((t)-(NT-4))-4*hi); } }while(0)
  #define ENDW(tt) do{ if((tt)+3<NT){WAIT_BAR(3);} else if((tt)+2<NT){WAIT_BAR(2);} else {WAIT_BAR(0);} }while(0)
  for(;t+1<NT;t+=2){
    STEP(pB0,pB1,pA0,pA1,t,(t+3<NT),(t+1<NT),(t+1<NT));       ENDW(t);   RESC(); ROT();
    STEP(pA0,pA1,pB0,pB1,t+1,(t+4<NT),(t+2<NT),(t+2<NT));     ENDW(t+1); RESC(); ROT();
  }
  STEP(pB0,pB1,pA0,pA1,NT-1,false,false,false); RESC();
  { float sacc=pB0[0]+pB0[1]; _Pragma("unroll") for(int r=2;r<16;++r)sacc+=pB0[r]; _Pragma("unroll") for(int r=0;r<16;++r)sacc+=pB1[r]; l_reg+=sacc;
    pw0=(u32x4){PKW(pB0,0),PKW(pB0,2),PKW(pB0,4),PKW(pB0,6)};pw1=(u32x4){PKW(pB0,8),PKW(pB0,10),PKW(pB0,12),PKW(pB0,14)};pw2=(u32x4){PKW(pB1,0),PKW(pB1,2),PKW(pB1,4),PKW(pB1,6)};pw3=(u32x4){PKW(pB1,8),PKW(pB1,10),PKW(pB1,12),PKW(pB1,14)};
    SBAR(); pv(o,vb0+2*sl_cur,PAF(0),PAF(1),PAF(2),PAF(3)); pv(o+2,vb0+2*sl_cur+8192,PAF(0),PAF(1),PAF(2),PAF(3)); }
  #undef PKW
  #undef PAF
  #undef VFR
  #undef PIN
  #undef MX3
  #undef GAPA
  #undef GAPB
  #undef EX
  #undef VRD
  #undef VRD2
  #undef KRD
  #undef STEP
  #undef ENDW
  {auto rr=__builtin_amdgcn_permlane32_swap(__float_as_uint(l_reg),__float_as_uint(l_reg),false,false);l_reg=__uint_as_float(rr[0])+__uint_as_float(rr[1]);}
  if(hi==0)wsf[32+r32]=l_reg;asm volatile("s_waitcnt lgkmcnt(0)":::"memory");
  float rli[16];
  #pragma unroll
  for(int r=0;r<16;++r)rli[r]=__builtin_amdgcn_rcpf(wsf[32+crow(r,hi)]);
  bf16*Ow=O+(long)(q0+wid*QBLK)*OPITCH;
  { bf16*stg=(bf16*)(shm+LDS_OST)+wid*2048;
    #pragma unroll
    for(int ps=0;ps<2;++ps){
      #pragma unroll
      for(int r=0;r<16;++r){const int orow=crow(r,hi);
        #pragma unroll
        for(int d0=0;d0<2;++d0)stg[orow*64+d0*32+r32]=__float2bfloat16(o[2*ps+d0][r]*rli[r]);}
      asm volatile("s_waitcnt lgkmcnt(0)":::"memory");
      #pragma unroll
      for(int i=0;i<4;++i){const int row=i*8+(lane>>3),ch=lane&7; const u32x4 v=*(const u32x4*)(stg+row*64+ch*8); ATTN_STORE16(Ow+(long)row*OPITCH+ps*64+ch*8,v);}
      asm volatile("s_waitcnt lgkmcnt(0)":::"memory"); } }
  asm volatile("s_waitcnt lgkmcnt(0)\n\ts_barrier":::"memory");
  #undef DMA_K
  #undef DMA_V
  #undef CMASK
  #undef BIAS
  #undef START
  #undef RESC
  #undef ROT
}
constexpr int ATTN_LDS_BYTES=LDS_BYTES;
#undef SBAR
#undef WAIT_BAR
}
#define LAS __attribute__((address_space(3)))
typedef unsigned short bf16;
typedef unsigned v4u __attribute__((ext_vector_type(4)));
typedef unsigned v2u __attribute__((ext_vector_type(2)));
typedef float f32x4 __attribute__((ext_vector_type(4)));
constexpr int NWAVES = 8, NT = 512;
constexpr int M = 16384, DMODEL = 1024, NIN = 5128, NPROJ = 5120, DFF = 2816, DFFE = 3584, NEXP = 8;
constexpr float LN_EPS = 1e-5f, SUBLN_EPS = 1e-5f, ALPHA = 1.4142135623730951f  , LOG2E = 1.4426950408889634f;
constexpr size_t MiB = 1u << 20;
constexpr size_t WS_CTL = 0;
constexpr size_t WS_BAR = 16384;
constexpr size_t WS_LOGF = 1 * MiB, WS_CUM = 2 * MiB, WS_EIDX = 3 * MiB, WS_GW = 3 * MiB + 256 * 1024, WS_POS = 3 * MiB + 512 * 1024, WS_TILEE = 3 * MiB + 768 * 1024;
constexpr size_t WS_STATS = 4 * MiB;
constexpr size_t WS_WIN = 16 * MiB, WS_WBR = 36 * MiB, WS_WO = 40 * MiB, WS_WGU = 44 * MiB, WS_WDN = 55 * MiB, WS_WEGU = 61 * MiB, WS_WEDN = 173 * MiB;
constexpr size_t WS_H = 229 * MiB, WS_HB = 293 * MiB;
constexpr size_t WS_PROJ = 325 * MiB, WS_YATT = 485 * MiB, WS_ODIFF = 517 * MiB, WS_T = 549 * MiB, WS_MERGED = 613 * MiB, WS_Z = 645 * MiB, WS_ACT = 709 * MiB;
constexpr size_t WS_XS = 325 * MiB, WS_ACTS = 393 * MiB, WS_YS = 709 * MiB, WS_END = 845 * MiB;
constexpr float W8_SCALE = 64.f, A8_SCALE = 16.f;
constexpr int MAXP = 2 * M + NEXP * 256;
static_assert(WS_XS + (size_t)MAXP * 1024 * 2 <= WS_ACTS && WS_ACTS + (size_t)MAXP * DFFE * 2 <= WS_Z && WS_YS + (size_t)MAXP * 1024 * 4 <= WS_END, "moe overlay");
static_assert(WS_PROJ + (size_t)M * NPROJ * 2 <= WS_YATT && WS_ACT + (size_t)M * DFF * 2 <= WS_END, "ws map");
constexpr int LDS_BYTES = attn_body::LDS_BYTES + 1024;
static_assert(attn_body::LDS_BYTES >= pg8::STAGE_BYTES && LDS_BYTES <= 163840, "lds");

__device__ __forceinline__ unsigned f2bf(float f) { unsigned u = __builtin_bit_cast(unsigned, f); return (u + 0x7fffu + ((u >> 16) & 1u)) >> 16; }
__device__ __forceinline__ unsigned pk2(float lo, float hi) { return f2bf(lo) | (f2bf(hi) << 16); }
__device__ __forceinline__ float wave_sum(float v) {
#pragma unroll
    for (int o = 1; o < 64; o <<= 1) v += shx(v, o);
    return v;
}
__device__ __forceinline__ void tr_block(const float* src  , int ldw, bf16* dst  , int K, LAS float* scr, int lane) {
    const int kr = lane >> 3, c4 = lane & 7;
    f32x4 v[8];
#pragma unroll
    for (int i = 0; i < 8; ++i) v[i] = *(const f32x4*)(src + (size_t)(8 * i + kr) * ldw + 4 * c4);
#pragma unroll
    for (int i = 0; i < 8; ++i) { LAS float* d = scr + (8 * i + kr) * 33 + 4 * c4; d[0] = v[i].x; d[1] = v[i].y; d[2] = v[i].z; d[3] = v[i].w; }
    asm volatile("s_waitcnt lgkmcnt(0)" ::: "memory");
    const int c = lane & 7;
#pragma unroll
    for (int j = 0; j < 4; ++j) { const int n = (lane >> 3) + 8 * j; const LAS float* s = scr + (8 * c) * 33 + n;
        v4u o; o.x = pk2(s[0 * 33], s[1 * 33]); o.y = pk2(s[2 * 33], s[3 * 33]); o.z = pk2(s[4 * 33], s[5 * 33]); o.w = pk2(s[6 * 33], s[7 * 33]);
        *(v4u*)(dst + (size_t)n * K + 8 * c) = o; }
    asm volatile("s_waitcnt lgkmcnt(0)" ::: "memory");
}
__device__ __forceinline__ void tr_block8(const float* src, int ldw, unsigned char* dst  , int Kb, float sc, LAS float* scr, int lane) {
    const int kr = lane >> 3, c4 = lane & 7;
    f32x4 v[8];
#pragma unroll
    for (int i = 0; i < 8; ++i) v[i] = *(const f32x4*)(src + (size_t)(8 * i + kr) * ldw + 4 * c4);
#pragma unroll
    for (int i = 0; i < 8; ++i) { LAS float* d = scr + (8 * i + kr) * 33 + 4 * c4; d[0] = v[i].x; d[1] = v[i].y; d[2] = v[i].z; d[3] = v[i].w; }
    asm volatile("s_waitcnt lgkmcnt(0)" ::: "memory");
    const int c = lane & 7;
#pragma unroll
    for (int j = 0; j < 4; ++j) { const int n = (lane >> 3) + 8 * j; const LAS float* s = scr + (8 * c) * 33 + n;
        int w0 = 0, w1 = 0; w0 = __builtin_amdgcn_cvt_pk_fp8_f32(s[0 * 33] * sc, s[1 * 33] * sc, w0, false); w0 = __builtin_amdgcn_cvt_pk_fp8_f32(s[2 * 33] * sc, s[3 * 33] * sc, w0, true);
        w1 = __builtin_amdgcn_cvt_pk_fp8_f32(s[4 * 33] * sc, s[5 * 33] * sc, w1, false); w1 = __builtin_amdgcn_cvt_pk_fp8_f32(s[6 * 33] * sc, s[7 * 33] * sc, w1, true);
        *(v2u*)(dst + (size_t)n * Kb + 8 * c) = (v2u){(unsigned)w0, (unsigned)w1}; }
    asm volatile("s_waitcnt lgkmcnt(0)" ::: "memory");
}
template <int MAP> __device__ __forceinline__ void tr_seg8(const float* W, int ldw, int K, int c0, int ncols, unsigned char* WT, int row_off, int F, float sc, LAS float* scr, int item, int lane) {
    const int nblk = ncols / 32, kb = item / nblk, nb = item % nblk, k0 = 64 * kb, n0 = 32 * nb;
    int drow;
    if (MAP == 0) drow = row_off + n0; else { int c = n0; const int up = c >= F; if (up) c -= F; drow = row_off + 256 * (c / 128) + 128 * up + (c % 128); }
    tr_block8(W + (size_t)k0 * ldw + c0 + n0, ldw, WT + (size_t)drow * K + k0, K, sc, scr, lane);
}
template <int MAP> __device__ __forceinline__ void tr_seg(const float* W, int ldw, int K, int c0, int ncols, bf16* WT, int row_off, int F, LAS float* scr, int item, int lane) {
    const int nblk = ncols / 32, kb = item / nblk, nb = item % nblk, k0 = 64 * kb, n0 = 32 * nb;
    int drow;
    if (MAP == 0) drow = row_off + n0; else { int c = n0; const int up = c >= F; if (up) c -= F; drow = row_off + 256 * (c / 128) + 128 * up + (c % 128); }
    tr_block(W + (size_t)k0 * ldw + c0 + n0, ldw, WT + (size_t)drow * K + k0, K, scr, lane);
}

#define XB_TMO      128
#define XB_XCNT(j)  (256  + 64 * (j))
#define XB_XSUB(j)  (1280 + 64 * (j))
#define XB_XGEN(j)  (2304 + 64 * (j))
#define XB_TOP      3328
#define XB_TOPGEN   3392
#define XCD_BAR_WORDS 3456
#define XB_SPIN_CAP (1u << 18)

__device__ __forceinline__ unsigned xb_ld(unsigned* p)              { return __hip_atomic_load(p, __ATOMIC_RELAXED, __HIP_MEMORY_SCOPE_AGENT); }
__device__ __forceinline__ unsigned xb_add(unsigned* p, unsigned v) { return __hip_atomic_fetch_add(p, v, __ATOMIC_RELAXED, __HIP_MEMORY_SCOPE_AGENT); }
__device__ __forceinline__ unsigned xb_xcc_id() { return (unsigned)__builtin_amdgcn_s_getreg((3 << 11) | 20) & 0xFu; }
#define XB_SPIN(cond, bar) do { unsigned _sp = 0; while (cond) { __builtin_amdgcn_s_sleep(1); \
    if ((++_sp & 255u) == 0u) { if (xb_ld(&(bar)[XB_TMO])) break; if (_sp > XB_SPIN_CAP) { atomicAdd(&(bar)[XB_TMO], 1u); break; } } } } while (0)

struct XcdBarrier {
    unsigned* bar; unsigned x;
    volatile LAS unsigned* st;
};

__device__ __forceinline__ XcdBarrier xcd_barrier_post(unsigned* bar, volatile LAS unsigned* st, const int wv) {
    XcdBarrier b; b.bar = bar; b.x = xb_xcc_id(); b.st = st;
    if (mk_tid(wv) == 0) (void)xb_add(&bar[XB_XCNT(b.x)], 1u);
    return b;
}
__device__ __forceinline__ void xcd_barrier_complete(unsigned* bar, unsigned x, unsigned& nloc, unsigned& nx) {
    const unsigned G = gridDim.x * gridDim.y * gridDim.z;
    unsigned sum, cnt, mine, sp = 0u;
    for (;;) {
        sum = 0u; cnt = 0u; mine = 0u;
#pragma unroll
        for (unsigned j = 0; j < 16; ++j) { const unsigned c = xb_ld(&bar[XB_XCNT(j)]); sum += c; cnt += (c > 0u) ? 1u : 0u; mine = (j == x) ? c : mine; }
        if (sum == G) break;
        __builtin_amdgcn_s_sleep(1);
        if ((++sp & 255u) == 0u) { if (xb_ld(&bar[XB_TMO])) break; if (sp > XB_SPIN_CAP) { atomicAdd(&bar[XB_TMO], 1u); break; } }
    }
    nloc = mine > 0u ? mine : 1u; nx = cnt > 0u ? cnt : 1u;
}

__device__ __forceinline__ void xcd_barrier(const XcdBarrier& b, const int wv) {
    asm volatile("s_waitcnt vmcnt(0)" ::: "memory");
    __syncthreads();
    if (mk_tid(wv) == 0) {
        unsigned* bar = b.bar;
        __builtin_amdgcn_s_waitcnt(0);
        unsigned nloc = b.st[0], nx = b.st[1];
        if (nloc == 0u) { xcd_barrier_complete(bar, b.x, nloc, nx); b.st[0] = nloc; b.st[1] = nx; }
        const unsigned old = xb_add(&bar[XB_XSUB(b.x)], 1u);
        const unsigned gen = old / nloc;
        if (old + 1u == (gen + 1u) * nloc) {
            __builtin_amdgcn_fence(__ATOMIC_RELEASE, "agent");
            asm volatile("s_waitcnt vmcnt(0)" ::: "memory");
            const unsigned og = xb_add(&bar[XB_TOP], 1u);
            const unsigned tg = og / nx;
            if (og + 1u == (tg + 1u) * nx) xb_add(&bar[XB_TOPGEN], 1u);
            else XB_SPIN(xb_ld(&bar[XB_TOPGEN]) == tg, bar);
            __builtin_amdgcn_fence(__ATOMIC_ACQUIRE, "agent");
            xb_add(&bar[XB_XGEN(b.x)], 1u);
            asm volatile("s_waitcnt vmcnt(0)" ::: "memory");
        } else {
            XB_SPIN(xb_ld(&bar[XB_XGEN(b.x)]) == gen, bar);
            __builtin_amdgcn_fence(__ATOMIC_ACQUIRE, "agent");
            asm volatile("s_waitcnt vmcnt(0)" ::: "memory");
        }
    }
    __syncthreads();
}

__device__ __forceinline__ unsigned char* launder(unsigned char* p) { asm volatile("" : "+s"(p)); return p; }
typedef const __attribute__((address_space(4))) unsigned char* karg_ptr;
__device__ __forceinline__ karg_ptr karg_base() { karg_ptr p = (karg_ptr)__builtin_amdgcn_kernarg_segment_ptr(); asm volatile("" : "+s"(p)); return p; }
struct KArgIn { __device__ __forceinline__ const float* operator[](int k) const { return *(const float* const __attribute__((address_space(4)))*)(karg_base() + 8 * k); } };
__device__ __forceinline__ float* karg_out() { return *(float* const __attribute__((address_space(4)))*)(karg_base() + 184); }
__device__ __forceinline__ unsigned char* karg_ws() { return *(unsigned char* const __attribute__((address_space(4)))*)(karg_base() + 192); }
struct Args { const float* in[23]; float* out; unsigned char* ws; };

template <int SRC, int EXTRA>
__device__ __forceinline__ void ln_phase(LAS unsigned char* lds, int G, const float* src, const pg8::PrevLN hp, const float* ys, const int* pos, const float* gwt, const int* tailid, const float* part,
                                         const float* g, const float* b, float* of32, float* stats, bf16* obf, const float* w8, int w8ld, const float* bf8, float* logf, int* eidx, float* gwout, unsigned* gcount, const int wv) {
    const int tid = mk_tid(wv); const int lane = tid & 63, wave = wv;
    LAS float* w8s = (LAS float*)lds;
    LAS unsigned* lcnt = (LAS unsigned*)(lds + 32768);
    if (EXTRA != 0) { for (int i = tid; i < 8192; i += NT) { const int k = i >> 3, j = i & 7; w8s[j * 1024 + k] = w8[(size_t)k * w8ld + j]; } if (tid < 8) lcnt[tid] = 0u; __syncthreads(); }
    f32x4 gv[4], bv[4];
#pragma unroll
    for (int j = 0; j < 4; ++j) { gv[j] = *(const f32x4*)(g + 256 * j + 4 * lane); bv[j] = *(const f32x4*)(b + 256 * j + 4 * lane); }
    const int gw = blockIdx.x * NWAVES + wave, NGW = G * NWAVES;
    for (int row = gw; row < M; row += NGW) {
        f32x4 v[4];
        if (SRC == 0) {
#pragma unroll
            for (int j = 0; j < 4; ++j) v[j] = *(const f32x4*)(src + (size_t)row * 1024 + 256 * j + 4 * lane);
        } else {
            const int p0 = pos[2 * row], p1 = pos[2 * row + 1]; const float w0 = gwt[2 * row], w1 = gwt[2 * row + 1]; const float hm = hp.stats[2 * row], hr = hp.stats[2 * row + 1];
#pragma unroll
            for (int j = 0; j < 4; ++j) { const f32x4 a = (*(const f32x4*)(hp.src + (size_t)row * 1024 + 256 * j + 4 * lane) - hm) * hr * *(const f32x4*)(hp.g + 256 * j + 4 * lane) + *(const f32x4*)(hp.b + 256 * j + 4 * lane);
                f32x4 y[2];
#pragma unroll
                for (int q = 0; q < 2; ++q) { const int p = q ? p1 : p0; const int t = __builtin_amdgcn_readfirstlane(tailid[(p >> 8) * 4 + j]);
                    if (t < 0) y[q] = *(const f32x4*)(ys + (size_t)p * 1024 + 256 * j + 4 * lane);
                    else { f32x4 acc = (f32x4){0.f, 0.f, 0.f, 0.f};
#pragma unroll
                        for (int sl = 0; sl < 7; ++sl) acc = acc + *(const f32x4*)(part + ((size_t)(t * 7 + sl) * 256 + (p & 255)) * 256 + 4 * lane);
                        y[q] = acc; } }
                v[j] = a * ALPHA + y[0] * w0 + y[1] * w1; }
        }
        float s = 0.f;
#pragma unroll
        for (int j = 0; j < 4; ++j) s += (v[j].x + v[j].y) + (v[j].z + v[j].w);
        const float mean = wave_sum(s) * (1.f / 1024.f); float s2 = 0.f;
#pragma unroll
        for (int j = 0; j < 4; ++j) { v[j] = v[j] - mean; s2 += (v[j].x * v[j].x + v[j].y * v[j].y) + (v[j].z * v[j].z + v[j].w * v[j].w); }
        const float rstd = 1.f / sqrtf(wave_sum(s2) * (1.f / 1024.f) + LN_EPS);
        if (stats && lane == 0) { stats[2 * row] = mean; stats[2 * row + 1] = rstd; }
#pragma unroll
        for (int j = 0; j < 4; ++j) { v[j] = v[j] * rstd * gv[j] + bv[j]; if (of32) *(f32x4*)(of32 + (size_t)row * 1024 + 256 * j + 4 * lane) = v[j];
            if (obf) { v2u o; o.x = pk2(v[j].x, v[j].y); o.y = pk2(v[j].z, v[j].w); *(v2u*)(obf + (size_t)row * 1024 + 256 * j + 4 * lane) = o; } }
        if (EXTRA != 0) {
            float d[8];
#pragma unroll
            for (int e = 0; e < 8; ++e) { float a = 0.f;
#pragma unroll
                for (int j = 0; j < 4; ++j) { const f32x4 w = *(const LAS f32x4*)(w8s + e * 1024 + 256 * j + 4 * lane); a += (v[j].x * w.x + v[j].y * w.y) + (v[j].z * w.z + v[j].w * w.w); }
                d[e] = wave_sum(a); }
            if (EXTRA == 1) {
                float x = d[0];
#pragma unroll
                for (int e = 1; e < 8; ++e) x = (lane == e) ? d[e] : x;
                if (lane < 8) { x += bf8[lane]; const float ls = (x >= 0.f) ? -log1pf(__expf(-x)) : (x - log1pf(__expf(x))); logf[(size_t)lane * M + row] = ls; }
            } else {
                int i0 = 0; float v0 = d[0];
#pragma unroll
                for (int e = 1; e < 8; ++e) if (d[e] > v0) { v0 = d[e]; i0 = e; }
                int i1 = -1; float v1 = -INFINITY;
#pragma unroll
                for (int e = 0; e < 8; ++e) if (e != i0 && d[e] > v1) { v1 = d[e]; i1 = e; }
                if (lane == 0) { const float w0 = 1.f / (1.f + __expf(v1 - v0)); eidx[row] = i0 | (i1 << 8); gwout[2 * row] = w0; gwout[2 * row + 1] = 1.f - w0;
                    atomicAdd((unsigned*)&lcnt[i0], 1u); atomicAdd((unsigned*)&lcnt[i1], 1u); }
            }
        }
    }
    if (EXTRA == 2) { __syncthreads(); if (tid < 8) atomicAdd(gcount + tid, lcnt[tid]); }
}

#define GSYNC_CG() do { if constexpr (SEL < 0) cg::this_grid().sync(); } while (0)
#define GSYNC() do { if constexpr (SEL < 0) { XcdBarrier b_; b_.bar = (unsigned*)(karg_ws() + WS_BAR); b_.x = xb_xcc_id(); b_.st = (volatile LAS unsigned*)(ldsp + attn_body::LDS_BYTES); xcd_barrier(b_, wv); } } while (0)
#define PHASE(id) if constexpr (SEL < 0 || SEL == (id))
#ifndef PHM
#define PHM 0xffffffffu
#endif
#ifndef REP_G
#define REP_G 1
#endif
#ifndef REP_A
#define REP_A 1
#endif
#ifndef REP_P
#define REP_P 1
#endif
#define GEMM_PHASE8(EpiT, SchedT, gg, SS, EE) pg8::gemm_phase<EpiT, SchedT, true, true, true>(ldsp, gg, SS, EE, wv)
#define GEMM_PHASE(EpiT, SchedT, gg, SS, EE) do { pg8::gemm_phase<EpiT, SchedT, true, true>(ldsp, gg, SS, EE, wv); if constexpr (REP_G > 1) { pg8::gemm_phase<EpiT, SchedT, true, true>(ldsp, gg, SS, EE, wv); } } while (0)

#define q_ctl ((unsigned*)(karg_ws() + WS_CTL))
#define q_logf ((float*)(karg_ws() + WS_LOGF))
#define q_cum ((float*)(karg_ws() + WS_CUM))
#define q_eidx ((int*)(karg_ws() + WS_EIDX))
#define q_gwt ((float*)(karg_ws() + WS_GW))
#define q_pos ((int*)(karg_ws() + WS_POS))
#define q_tile_e ((int*)(karg_ws() + WS_TILEE))
#define q_Win_t ((bf16*)(karg_ws() + WS_WIN))
#define q_Wbr_t ((bf16*)(karg_ws() + WS_WBR))
#define q_Wo_t ((bf16*)(karg_ws() + WS_WO))
#define q_Wgu_t ((bf16*)(karg_ws() + WS_WGU))
#define q_Wdn_t ((bf16*)(karg_ws() + WS_WDN))
#define q_Wegu_t ((bf16*)(karg_ws() + WS_WEGU))
#define q_Wedn_t ((bf16*)(karg_ws() + WS_WEDN))
#define q_h ((float*)(karg_ws() + WS_H))
#define q_stats ((float*)(karg_ws() + WS_STATS))
#define q_hb ((bf16*)(karg_ws() + WS_HB))
#define q_proj ((bf16*)(karg_ws() + WS_PROJ))
#define q_yatt ((bf16*)(karg_ws() + WS_YATT))
#define q_odiff ((bf16*)(karg_ws() + WS_ODIFF))
#define q_Tb ((float*)(karg_ws() + WS_T))
#define q_merged ((bf16*)(karg_ws() + WS_MERGED))
#define q_z ((float*)(karg_ws() + WS_Z))
#define q_act ((bf16*)(karg_ws() + WS_ACT))
#define q_Xs ((bf16*)(karg_ws() + WS_XS))
#define q_acts ((bf16*)(karg_ws() + WS_ACTS))
#define q_ys ((float*)(karg_ws() + WS_YS))
#define in KArgIn()

__device__ __forceinline__ int tid_fresh(int wv) { return mk_tid(wv); }
#define FRESH_IDS() const int tid = tid_fresh(wv), lane = tid & 63, wave = wv
template <int l, int SEL> __device__ __forceinline__ void layer_body(const Args& args, LAS unsigned char* ldsp, unsigned char* lds, const int G, const int bx, const int vcu, const int wv) {
        constexpr int B = 1 + 10 * l;
        PHASE(B + 0) {
        if (bx < 8) {
            FRESH_IDS();
            const float* lf = q_logf + (size_t)bx * M + 32 * tid; float* co = q_cum + (size_t)bx * M + 32 * tid;
            f32x4 v[8]; float run = 0.f;
#pragma unroll
            for (int j = 0; j < 8; ++j) { v[j] = *(const f32x4*)(lf + 4 * j); v[j].x += run; v[j].y += v[j].x; v[j].z += v[j].y; v[j].w += v[j].z; run = v[j].w; }
            float inc = run;
#pragma unroll
            for (int o = 1; o < 64; o <<= 1) { const float t = __shfl_up(inc, o); if (lane >= o) inc += t; }
            LAS float* wt = (LAS float*)ldsp;
            if (lane == 63) wt[wave] = inc;
            __syncthreads();
            float base = inc - run;
            for (int w = 0; w < wave; ++w) base += wt[w];
#pragma unroll
            for (int j = 0; j < 8; ++j) *(f32x4*)(co + 4 * j) = v[j] + base;
            __syncthreads();
        }
        {
            pg8::Gemm g{q_hb, q_Win_t + (size_t)l * NPROJ * 1024, M, NPROJ, 1024}; pg8::StaticOrder S; S.init(M, NPROJ, G, bx);
            pg8::EpiProj E{q_proj, attn_body::C2, q_ctl + 16};
            if (PHM & (1u << 1)) GEMM_PHASE(pg8::EpiProj, pg8::StaticOrder, g, S, E);
#ifdef REP_INPROJ
            GEMM_PHASE(pg8::EpiProj, pg8::StaticOrder, g, S, E);
#endif
        }
        }
        GSYNC();

        PHASE(B + 1) {
            typedef attn_body::bf16 abf;
            const abf* pj = (const abf*)q_proj;
#ifndef NO_ATTN0
            for (int p = vcu; p < 256; p += G) { const int vh = p >> 5, s = p & 31;
                const unsigned* nr = q_ctl + 16; const float qn = sqrtf(__uint_as_float(nr[2 * vh]) + __uint_as_float(nr[2 * vh + 1])), kn = sqrtf(__uint_as_float(nr[16 + 2 * vh]) + __uint_as_float(nr[16 + 2 * vh + 1]));
                const float thr = 2.04f * qn * kn + 40.f;
                for (int half = 0; half < 2; ++half) { const int qb = half ? 63 - s : s;
                    attn_body::attn_unit<0, 8>(qb, pj + (size_t)vh * M * 64, pj + (size_t)(8 + vh) * M * 64, pj + (size_t)(16 + vh) * M * 64, (abf*)q_yatt + vh * 64, q_cum + (size_t)vh * M, nullptr, thr, (char*)lds, wv); } }
#endif
#ifndef NO_ATTN1
            for (int p = 256 + vcu; p < 512; p += G) { const int d = (p >> 5) - 8, s = p & 31, hd = d >> 1, c = d & 1;
                for (int half = 0; half < 2; ++half) { const int qb = half ? 63 - s : s;
                    attn_body::attn_unit_d<8>(qb, pj + (size_t)(24 + d) * M * 64, pj + (size_t)(32 + d) * M * 64, pj + (size_t)5 * 512 * M + (size_t)hd * M * 128, (abf*)q_odiff + (size_t)c * M * 512 + hd * 128, nullptr, in[15] + hd, 0.f, (char*)lds, wv); } }
#endif
            if constexpr (REP_A > 1) {
#ifndef NO_DUP0
            for (int p = vcu; p < 256; p += G) { const int vh = p >> 5, s = p & 31;
                const unsigned* nr = q_ctl + 16; const float qn = sqrtf(__uint_as_float(nr[2 * vh]) + __uint_as_float(nr[2 * vh + 1])), kn = sqrtf(__uint_as_float(nr[16 + 2 * vh]) + __uint_as_float(nr[16 + 2 * vh + 1]));
                const float thr = 2.04f * qn * kn + 40.f;
                for (int half = 0; half < 2; ++half) { const int qb = half ? 63 - s : s;
                    attn_body::attn_unit<0, 8>(qb, pj + (size_t)vh * M * 64, pj + (size_t)(8 + vh) * M * 64, pj + (size_t)(16 + vh) * M * 64, (abf*)q_yatt + vh * 64, q_cum + (size_t)vh * M, nullptr, thr, (char*)lds, wv); } }
#endif
#ifndef NO_DUP1
            for (int p = 256 + vcu; p < 512; p += G) { const int d = (p >> 5) - 8, s = p & 31, hd = d >> 1, c = d & 1;
                for (int half = 0; half < 2; ++half) { const int qb = half ? 63 - s : s;
                    attn_body::attn_unit_d<8>(qb, pj + (size_t)(24 + d) * M * 64, pj + (size_t)(32 + d) * M * 64, pj + (size_t)5 * 512 * M + (size_t)hd * M * 128, (abf*)q_odiff + (size_t)c * M * 512 + hd * 128, nullptr, in[15] + hd, 0.f, (char*)lds, wv); } }
#endif
            }
        }
        GSYNC();

        PHASE(B + 2) {
            FRESH_IDS();
            const float lam_init = 0.8f - 0.6f * expf(-0.3f * (float)l);
            const float a1 = wave_sum(in[5][l * 64 + lane] * in[6][l * 64 + lane]), a2 = wave_sum(in[7][l * 64 + lane] * in[8][l * 64 + lane]);
            const float lam = expf(a1) - expf(a2) + lam_init;
            const float* sg = in[9] + l * 128 + (lane & 15) * 8; float gsc[8];
#pragma unroll
            for (int i = 0; i < 8; ++i) gsc[i] = sg[i] * (1.f - lam_init);
            const int gw = bx * NWAVES + wave, NGW = G * NWAVES;
            for (int row = gw; row < M; row += NGW) {
                const v4u a = *(const v4u*)(q_odiff + (size_t)row * 512 + 8 * lane), b = *(const v4u*)(q_odiff + (size_t)(M + row) * 512 + 8 * lane);
                float o[8]; const unsigned aw[4] = {a.x, a.y, a.z, a.w}, bw[4] = {b.x, b.y, b.z, b.w};
#pragma unroll
                for (int i = 0; i < 4; ++i) { o[2 * i] = pg8::bf_lo(aw[i]) - lam * pg8::bf_lo(bw[i]); o[2 * i + 1] = pg8::bf_hi(aw[i]) - lam * pg8::bf_hi(bw[i]); }
                float ss = 0.f;
#pragma unroll
                for (int i = 0; i < 8; ++i) ss += o[i] * o[i];
                ss += shx(ss, 1); ss += shx(ss, 2); ss += shx(ss, 4); ss += shx(ss, 8);
                const float r = 1.f / sqrtf(ss * (1.f / 128.f) + SUBLN_EPS);
                v4u w; w.x = pk2(o[0] * r * gsc[0], o[1] * r * gsc[1]); w.y = pk2(o[2] * r * gsc[2], o[3] * r * gsc[3]); w.z = pk2(o[4] * r * gsc[4], o[5] * r * gsc[5]); w.w = pk2(o[6] * r * gsc[6], o[7] * r * gsc[7]);
                *(v4u*)(q_yatt + (size_t)(M + row) * 512 + 8 * lane) = w;
            }
        }
        GSYNC();

        PHASE(B + 3) {
            pg8::Gemm g{q_yatt, q_Wbr_t + (size_t)l * 2048 * 512, 2 * M, 2048, 512}; pg8::MergeOrder S; S.b.init(M, 1024, G, bx);
            pg8::EpiMerge E{q_proj, q_Tb, q_merged};
            if (PHM & (1u << 2)) GEMM_PHASE(pg8::EpiMerge, pg8::MergeOrder, g, S, E);
        }
        GSYNC();
        PHASE(B + 4) {
            pg8::Gemm g{q_merged, q_Wo_t + (size_t)l * 1024 * 1024, M, 1024, 1024}; pg8::StaticOrder S; S.init(M, 1024, G, bx);
            pg8::EpiResid E{l == 0 ? pg8::PrevLN{in[0], q_stats, in[1], in[2]} : pg8::PrevLN{q_z, q_stats, in[21], in[22]}, q_z, ALPHA};
            if (PHM & (1u << 3)) GEMM_PHASE(pg8::EpiResid, pg8::StaticOrder, g, S, E);
        }
        GSYNC();
        PHASE(B + 5) {
        if constexpr (l == 0) { if (PHM & (1u << 12)) ln_phase<0, 0>(ldsp, G, q_z, pg8::PrevLN{nullptr, nullptr, nullptr, nullptr}, nullptr, nullptr, nullptr, nullptr, nullptr, in[13], in[14], nullptr, q_stats, q_hb, nullptr, 0, nullptr, nullptr, nullptr, nullptr, nullptr, wv); }
        else { if (PHM & (1u << 13)) ln_phase<0, 2>(ldsp, G, q_z, pg8::PrevLN{nullptr, nullptr, nullptr, nullptr}, nullptr, nullptr, nullptr, nullptr, nullptr, in[13] + 1024, in[14] + 1024, nullptr, q_stats, q_hb, in[18], 8, nullptr, nullptr, q_eidx, q_gwt, q_ctl, wv); }
        }
        GSYNC();

        if constexpr (l == 0) {
            PHASE(B + 6) {
                pg8::Gemm g{q_hb, q_Wgu_t, M, 2 * DFF, 1024}; pg8::StaticOrder S; S.init(M, 2 * DFF, G, bx);
                pg8::EpiSwiglu E{q_act, DFF, 1 << 20};
                if (PHM & (1u << 4)) GEMM_PHASE(pg8::EpiSwiglu, pg8::StaticOrder, g, S, E);
            }
            GSYNC();
            PHASE(B + 7) {
                pg8::Gemm g{q_act, q_Wdn_t, M, 1024, DFF}; pg8::StaticOrder S; S.init(M, 1024, G, bx);
                pg8::EpiResid E{pg8::PrevLN{q_z, q_stats, in[13], in[14]}, q_z, ALPHA};
                if (PHM & (1u << 5)) GEMM_PHASE(pg8::EpiResid, pg8::StaticOrder, g, S, E);
            }
            GSYNC();
            PHASE(B + 8) if (PHM & (1u << 14)) ln_phase<0, 1>(ldsp, G, q_z, pg8::PrevLN{nullptr, nullptr, nullptr, nullptr}, nullptr, nullptr, nullptr, nullptr, nullptr, in[21], in[22], nullptr, q_stats, q_hb, in[3] + (size_t)1024 * NIN + 1536, NIN, in[4] + 8, q_logf, nullptr, nullptr, nullptr, wv);
            GSYNC();
        } else {
            PHASE(B + 6) {
                FRESH_IDS();
                LAS int* li = (LAS int*)ldsp;
                if (tid < 8) { li[tid] = 0; li[32 + tid] = (int)q_ctl[tid]; }
                __syncthreads();
                if (tid == 0) { int o = 0; for (int e = 0; e < 8; ++e) { li[16 + e] = o; o += (li[32 + e] + 255) & ~255; } li[24] = o; }
                __syncthreads();
                const int npad_rows = li[24];
                if (bx == 0) { for (int t = tid; t < 240; t += NT) { int e = 0; for (int q = 1; q < 8; ++q) if (t * 256 >= li[16 + q]) e = q; q_tile_e[t] = e; } if (tid == 0) q_tile_e[255] = npad_rows / 256; }
                for (int tb = bx * 64; tb < M; tb += G * 64) {
                    int e = 0, r = 0, tok = 0;
                    if (tid < 128) { tok = tb + (tid >> 1); const int ei = q_eidx[tok]; e = (tid & 1) ? (ei >> 8) & 0xff : ei & 0xff; r = atomicAdd((int*)&li[e], 1); }
                    __syncthreads();
                    if (tid < 8) { li[8 + tid] = (int)atomicAdd(q_ctl + 8 + tid, (unsigned)li[tid]); }
                    __syncthreads();
                    if (tid < 128) { const int p = li[16 + e] + li[8 + e] + r; q_pos[2 * tok + (tid & 1)] = p; ((LAS int*)ldsp)[64 + tid] = p; }
                    __syncthreads();
                    if (tid < 8) li[tid] = 0;
                    for (int sidx = wave; sidx < 128; sidx += NWAVES) { const int p = ((LAS int*)ldsp)[64 + sidx]; const int tk = tb + (sidx >> 1);
                        { const v4u a = *(const v4u*)(q_hb + (size_t)tk * 1024 + 16 * lane), b = *(const v4u*)(q_hb + (size_t)tk * 1024 + 16 * lane + 8); v4u o; int w;
                            w = 0; w = __builtin_amdgcn_cvt_pk_fp8_f32(pg8::bf_lo(a.x), pg8::bf_hi(a.x), w, false); w = __builtin_amdgcn_cvt_pk_fp8_f32(pg8::bf_lo(a.y), pg8::bf_hi(a.y), w, true); o.x = (unsigned)w;
                            w = 0; w = __builtin_amdgcn_cvt_pk_fp8_f32(pg8::bf_lo(a.z), pg8::bf_hi(a.z), w, false); w = __builtin_amdgcn_cvt_pk_fp8_f32(pg8::bf_lo(a.w), pg8::bf_hi(a.w), w, true); o.y = (unsigned)w;
                            w = 0; w = __builtin_amdgcn_cvt_pk_fp8_f32(pg8::bf_lo(b.x), pg8::bf_hi(b.x), w, false); w = __builtin_amdgcn_cvt_pk_fp8_f32(pg8::bf_lo(b.y), pg8::bf_hi(b.y), w, true); o.z = (unsigned)w;
                            w = 0; w = __builtin_amdgcn_cvt_pk_fp8_f32(pg8::bf_lo(b.z), pg8::bf_hi(b.z), w, false); w = __builtin_amdgcn_cvt_pk_fp8_f32(pg8::bf_lo(b.w), pg8::bf_hi(b.w), w, true); o.w = (unsigned)w;
                            *(v4u*)((unsigned char*)q_Xs + (size_t)p * 1024 + 16 * lane) = o; } }
                    __syncthreads();
                }
                if (bx == 0) {
                    const int nMt = npad_rows / 256, nwg = nMt * 4, lim = pg8::main_units(nwg, G); int* tl = q_tile_e + 8192;
                    pg8::i32x4* tm = (pg8::i32x4*)(q_tile_e + 1024); pg8::i32x4* tt = (pg8::i32x4*)(q_tile_e + 4096);
                    for (int t = tid; t < nwg; t += NT) tl[t] = -1;
                    __syncthreads();
                    for (int L = tid; L < nwg; L += NT) { pg8::Unit u; pg8::map_unit(L, nMt, 4, u); int e = 0; for (int q = 1; q < 8; ++q) if (u.pm * 256 >= li[16 + q]) e = q;
                        if (L < lim) tm[L] = (pg8::i32x4){u.pm, u.pn + 4 * e, 0, 0};
                        else { tl[u.pm * 4 + u.pn] = L - lim; for (int sl = 0; sl < pg8::TAIL_KS; ++sl) tt[(L - lim) * pg8::TAIL_KS + sl] = (pg8::i32x4){u.pm, u.pn + 4 * e, sl * pg8::TAIL_K, (L - lim) * pg8::TAIL_KS + sl}; } }
                    if (tid == 0) { q_tile_e[254] = lim; q_tile_e[253] = (nwg - lim) * pg8::TAIL_KS; }
                }
                for (int e = 0; e < 8; ++e) { const int c = li[32 + e], st = li[16 + e] + c, en = li[16 + e] + ((c + 255) & ~255);
                    for (int rr = st + bx * NWAVES + wave; rr < en; rr += G * NWAVES) {
                        *(v4u*)((unsigned char*)q_Xs + (size_t)rr * 1024 + 16 * lane) = (v4u){0u, 0u, 0u, 0u}; } }
            }
            GSYNC();
            PHASE(B + 7) {
                const int mrows = __builtin_amdgcn_readfirstlane(q_tile_e[255]) * 256;
                pg8::Gemm g{q_Xs, q_Wegu_t, mrows, 2 * DFFE, 512}; pg8::MoeOrder S; S.b.init(mrows, 2 * DFFE, G, bx); S.te = q_tile_e; S.nper = 28;
                pg8::EpiSwiglu8 E{(unsigned char*)q_acts, DFFE, 28, 1.f / W8_SCALE, A8_SCALE};
                if (PHM & (1u << 6)) GEMM_PHASE8(pg8::EpiSwiglu8, pg8::MoeOrder, g, S, E);
            }
            GSYNC();
            PHASE(B + 8) {
                const int mrows = __builtin_amdgcn_readfirstlane(q_tile_e[255]) * 256, lim = __builtin_amdgcn_readfirstlane(q_tile_e[254]), nsub = __builtin_amdgcn_readfirstlane(q_tile_e[253]);
                {
                    pg8::Gemm g{q_acts, q_Wedn_t, mrows, 1024, DFFE / 2}; pg8::TableOrder S{(const pg8::i32x4*)(q_tile_e + 1024), lim, G, bx};
                    pg8::EpiStoreF32 E{q_ys, 4, 1.f / (W8_SCALE * A8_SCALE)};
                    if (PHM & (1u << 7)) GEMM_PHASE8(pg8::EpiStoreF32, pg8::TableOrder, g, S, E);
                }
                if (nsub > 0) {
                    pg8::Gemm g{q_acts, q_Wedn_t, mrows, 1024, pg8::TAIL_K, DFFE / 2}; pg8::TableOrder S{(const pg8::i32x4*)(q_tile_e + 4096), nsub, G, bx};
                    pg8::EpiStoreTail E{q_h, 1.f / (W8_SCALE * A8_SCALE)};
                    GEMM_PHASE8(pg8::EpiStoreTail, pg8::TableOrder, g, S, E);
                }
            }
            GSYNC();
            PHASE(B + 9) if (PHM & (1u << 15)) ln_phase<1, 0>(ldsp, G, nullptr, pg8::PrevLN{q_z, q_stats, in[13] + 1024, in[14] + 1024}, q_ys, q_pos, q_gwt, q_tile_e + 8192, q_h, in[21] + 1024, in[22] + 1024, karg_out(), nullptr, nullptr, nullptr, 0, nullptr, nullptr, nullptr, nullptr, nullptr, wv);
        }
}

template <int SEL> __global__ void __launch_bounds__(NWAVES * 64, 2) fwd_kernel(Args args) {
    extern __shared__ __attribute__((aligned(16))) unsigned char lds[];
    LAS unsigned char* ldsp = (LAS unsigned char*)lds;
    const int G = gridDim.x, bx = blockIdx.x; const int vcu = (G % 8 == 0) ? (bx % 8) * (G / 8) + bx / 8 : bx;
    const int wv = __builtin_amdgcn_readfirstlane((int)threadIdx.x >> 6);
    if constexpr (SEL < 0) { const int t0_ = mk_tid(wv); if (t0_ < 2) ((volatile LAS unsigned*)(ldsp + attn_body::LDS_BYTES))[t0_] = 0u; __syncthreads();
        (void)xcd_barrier_post((unsigned*)(karg_ws() + WS_BAR), (volatile LAS unsigned*)(ldsp + attn_body::LDS_BYTES), wv); }
    PHASE(0) {
        FRESH_IDS();
        LAS float* scr = (LAS float*)(ldsp + wave * 16384);
        const int gw = vcu * NWAVES + wave, NGW = G * NWAVES;
        constexpr int I_A = 16 * 48, I_B = 16 * 112, I_BR = 8 * 32, I_O = 16 * 32, I_L = I_A + I_B + 2 * I_BR + I_O;
        constexpr int I_GU = 16 * 176, I_DN = 44 * 32, I_EGU = 16 * 224, I_EDN = 56 * 32;
        constexpr int NITEMS = 2 * I_L + I_GU + I_DN + 8 * I_EGU + 8 * I_EDN;
        _Pragma("nounroll") for (int repp_ = 0; repp_ < REP_P; ++repp_)
        for (int it = gw; it < NITEMS; it += NGW) {
            int r = it;
            if (r < 2 * I_L) { const int l = r / I_L; r -= l * I_L; const float* win = in[3] + (size_t)l * 1024 * NIN; bf16* wt = q_Win_t + (size_t)l * NPROJ * 1024;
                if (r < I_A) { tr_seg<0>(win, NIN, 1024, 0, 1536, wt, 0, 0, scr, r, lane); continue; } r -= I_A;
                if (r < I_B) { tr_seg<0>(win, NIN, 1024, 1544, 3584, wt, 1536, 0, scr, r, lane); continue; } r -= I_B;
                if (r < I_BR) { tr_seg<0>(in[10] + (size_t)l * 512 * 1024, 1024, 512, 0, 1024, q_Wbr_t + (size_t)l * 2048 * 512, 0, 0, scr, r, lane); continue; } r -= I_BR;
                if (r < I_BR) { tr_seg<0>(in[11] + (size_t)l * 512 * 1024, 1024, 512, 0, 1024, q_Wbr_t + (size_t)l * 2048 * 512, 1024, 0, scr, r, lane); continue; } r -= I_BR;
                tr_seg<0>(in[12] + (size_t)l * 1024 * 1024, 1024, 1024, 0, 1024, q_Wo_t + (size_t)l * 1024 * 1024, 0, 0, scr, r, lane); continue; }
            r -= 2 * I_L;
            if (r < I_GU) { tr_seg<1>(in[16], 2 * DFF, 1024, 0, 2 * DFF, q_Wgu_t, 0, DFF, scr, r, lane); continue; } r -= I_GU;
            if (r < I_DN) { tr_seg<0>(in[17], 1024, DFF, 0, 1024, q_Wdn_t, 0, 0, scr, r, lane); continue; } r -= I_DN;
            if (r < 8 * I_EGU) { const int e = r / I_EGU; r -= e * I_EGU; tr_seg8<1>(in[19] + (size_t)e * 1024 * 2 * DFFE, 2 * DFFE, 1024, 0, 2 * DFFE, (unsigned char*)q_Wegu_t + (size_t)e * 2 * DFFE * 1024, 0, DFFE, W8_SCALE, scr, r, lane); continue; } r -= 8 * I_EGU;
            { const int e = r / I_EDN; r -= e * I_EDN; tr_seg8<0>(in[20] + (size_t)e * DFFE * 1024, 1024, DFFE, 0, 1024, (unsigned char*)q_Wedn_t + (size_t)e * 1024 * DFFE, 0, 0, W8_SCALE, scr, r, lane); }
        }
        __syncthreads();
        if (PHM & (1u << 11)) ln_phase<0, 1>(ldsp, G, in[0], pg8::PrevLN{nullptr, nullptr, nullptr, nullptr}, nullptr, nullptr, nullptr, nullptr, nullptr, in[1], in[2], nullptr, q_stats, q_hb, in[3] + 1536, NIN, in[4], q_logf, nullptr, nullptr, nullptr, wv);
    }
    GSYNC_CG();

    layer_body<0, SEL>(args, ldsp, lds, G, bx, vcu, wv);
    layer_body<1, SEL>(args, ldsp, lds, G, bx, vcu, wv);
}

#undef q_ctl
#undef q_logf
#undef q_cum
#undef q_eidx
#undef q_gwt
#undef q_pos
#undef q_tile_e
#undef q_Win_t
#undef q_Wbr_t
#undef q_Wo_t
#undef q_Wgu_t
#undef q_Wdn_t
#undef q_Wegu_t
#undef q_Wedn_t
#undef q_h
#undef q_stats
#undef q_hb
#undef q_proj
#undef q_yatt
#undef q_odiff
#undef q_Tb
#undef q_merged
#undef q_z
#undef q_act
#undef q_Xs
#undef q_acts
#undef q_ys
#undef in
#ifndef N_LAUNCH_MODE
#define N_LAUNCH_MODE 0
#endif
template <int S> static void launch_sel(int grid, Args& a, hipStream_t stream) {
    static bool attr = false;
    if (!attr) { (void)hipFuncSetAttribute((const void*)fwd_kernel<S>, hipFuncAttributeMaxDynamicSharedMemorySize, LDS_BYTES); attr = true; }
    hipLaunchKernelGGL(fwd_kernel<S>, dim3(grid), dim3(NWAVES * 64), LDS_BYTES, stream, a);
}
template <int S> static void launch_all(int grid, Args& a, hipStream_t stream) {
    if constexpr (S <= 20) { if constexpr (S != 10) launch_sel<S>(grid, a, stream); launch_all<S + 1>(grid, a, stream); }
}
extern "C" void kernel_launch(void* const* d_in, const int* in_sizes, int n_in, void* d_out, int out_size, void* d_ws, size_t ws_size, hipStream_t stream) {
    static int grid = 0;
    if (grid == 0) {
        if (n_in != 23 || out_size != M * DMODEL || ws_size < WS_END) { fprintf(stderr, "kernel_launch: unexpected shapes (n_in %d, out %d, ws %zu)\n", n_in, out_size, ws_size); grid = -1; return; }
        int dev = 0, cus = 0;
        (void)hipGetDevice(&dev); (void)hipDeviceGetAttribute(&cus, hipDeviceAttributeMultiprocessorCount, dev);
#if N_LAUNCH_MODE == 0
        int per_cu = 0;
        if (hipFuncSetAttribute((const void*)fwd_kernel<-1>, hipFuncAttributeMaxDynamicSharedMemorySize, LDS_BYTES) != hipSuccess) { fprintf(stderr, "kernel_launch: hipFuncSetAttribute failed\n"); grid = -1; return; }
        if (hipOccupancyMaxActiveBlocksPerMultiprocessor(&per_cu, (const void*)fwd_kernel<-1>, NWAVES * 64, LDS_BYTES) != hipSuccess || per_cu < 1) { fprintf(stderr, "kernel_launch: occupancy query says %d\n", per_cu); }
        (void)hipGetLastError();
#endif
        grid = cus;
    }
    if (grid < 0) return;
    (void)hipMemsetAsync((char*)d_ws + WS_CTL, 0, 32768, stream);
    Args a{};
    for (int i = 0; i < 23; ++i) a.in[i] = (const float*)d_in[i];
    a.out = (float*)d_out; a.ws = (unsigned char*)d_ws;
#if N_LAUNCH_MODE == 0
    void* kargs[] = {&a};
    hipError_t e = hipLaunchCooperativeKernel((const void*)fwd_kernel<-1>, dim3(grid), dim3(NWAVES * 64), kargs, LDS_BYTES, stream);
    if (e != hipSuccess) fprintf(stderr, "cooperative launch failed: %s (grid %d)\n", hipGetErrorString(e), grid);
#else
    launch_all<0>(grid, a, stream);
#endif
}
```

```cpp
#include <hip/hip_runtime.h>
#include <hip/hip_cooperative_groups.h>
#include <hip/hip_bf16.h>
#include <cstdio>
#include <cstdint>
#include <cmath>
namespace cg = cooperative_groups;
__device__ __forceinline__ int lane_now() { int l; asm volatile("v_mbcnt_lo_u32_b32 %0, -1, 0\n\tv_mbcnt_hi_u32_b32 %0, -1, %0" : "=v"(l)); return l; }
__device__ __forceinline__ int mk_tid(int wv) { return (wv << 6) | lane_now(); }
__device__ __forceinline__ float shx(float v, int o) { const int l = lane_now(); return __int_as_float(__builtin_amdgcn_ds_bpermute((l ^ o) << 2, __float_as_int(v))); }
namespace pg8 {
#define PG8_LAS __attribute__((address_space(3)))
typedef unsigned short bf16_t;
typedef short bf16x8 __attribute__((ext_vector_type(8)));
typedef float f32x4 __attribute__((ext_vector_type(4)));
typedef unsigned u32x4 __attribute__((ext_vector_type(4)));
constexpr int BM = 256, BK = 64, HALF = 128, HTB = HALF * BK * 2  , STAGE_BYTES = 8 * HTB, NXCD = 8, WGM = 8;

__host__ __device__ __forceinline__ int lds_byte(int r, int c) { const int st = (r >> 4) * 2 + (c >> 5), rr = r & 15, cc = c & 31, ob = rr * 64 + cc * 2; return st * 1024 + (ob ^ (((ob >> 9) & 1) << 5)); }
__host__ __device__ __forceinline__ void stage_rc(int b, int& R, int& C) { const int st = b / 1024, sb = b % 1024, swz = sb ^ (((sb >> 9) & 1) << 5); R = (st >> 1) * 16 + swz / 64; C = (st & 1) * 32 + (swz % 64) / 2; }
__host__ __device__ __forceinline__ int perm32(int rho) { const int n = rho >> 4, i = rho & 15; return 8 * (i >> 2) + 4 * n + (i & 3); }

struct Unit { int pm, pn; int koff = 0; int aux = 0; };
struct Gemm { const bf16_t* A; const bf16_t* Bt; int M, N, K; int ld = 0; };

struct StaticOrder {
    int nM, nN, nwg, G, c;
    __host__ __device__ void init(int M, int N, int G_, int c_) { nM = M / BM; nN = N / BM; nwg = nM * nN; G = G_; c = c_; }
    __host__ __device__ bool next(int i, Unit& u) const {
        const long L = (long)i * G + c; if (L >= nwg) return false;
        int wgid = (int)L; { const int q = nwg / NXCD, r = nwg % NXCD, xcd = wgid % NXCD, off = wgid / NXCD; wgid = (xcd < r ? xcd * (q + 1) : r * (q + 1) + (xcd - r) * q) + off; }
        const int nig = WGM * nN, gid = wgid / nig, fm = gid * WGM, gsz = (nM - fm) < WGM ? (nM - fm) : WGM;
        u.pm = fm + ((wgid % nig) % gsz); u.pn = (wgid % nig) / gsz; return true;
    }
    __device__ __forceinline__ void a_ready(const Unit&) const {}
    __device__ __forceinline__ void done(const Unit&) const {}
};

__device__ __forceinline__ unsigned cvt_pk_bf16(float lo, float hi) { unsigned r; asm volatile("v_cvt_pk_bf16_f32 %0, %1, %2" : "=v"(r) : "v"(lo), "v"(hi)); return r; }
__device__ __forceinline__ float sigm(float x) { return __builtin_amdgcn_rcpf(1.f + __builtin_amdgcn_exp2f(-1.4426950408889634f * x)); }
__device__ __forceinline__ float bf_lo(unsigned w) { return __uint_as_float(w << 16); }
__device__ __forceinline__ float bf_hi(unsigned w) { return __uint_as_float(w & 0xffff0000u); }
constexpr int NPROJ = 5120, M_ROWS = 16384;
struct EpiProj {
    static constexpr bool PERM = true, AFTER_DRAIN = false;
    bf16_t* O; float qscale; unsigned* nrm;
    __device__ __forceinline__ void operator()(const f32x4 (&acc)[2][2][4][2], const Unit& u, int wr, int wc, int fr, int fq) const {
        const int pn = u.pn; const float sc = (pn < 2 || (pn >= 6 && pn < 8)) ? qscale : 1.f; const bool gate = pn >= 12;
        const int row0 = u.pm * BM + wr * 64 + fr;
        const int seg = pn >> 1;
#pragma unroll
        for (int ai = 0; ai < 2; ++ai)
#pragma unroll
            for (int m = 0; m < 4; ++m) { const size_t row = (size_t)(row0 + ai * HALF + m * 16);
#pragma unroll
                for (int bj = 0; bj < 2; ++bj) { f32x4 v0 = acc[ai][bj][m][0], v1 = acc[ai][bj][m][1];
                    if (gate) { v0 = (f32x4){sigm(v0[0]), sigm(v0[1]), sigm(v0[2]), sigm(v0[3])}; v1 = (f32x4){sigm(v1[0]), sigm(v1[1]), sigm(v1[2]), sigm(v1[3])}; }
                    else { v0 = v0 * sc; v1 = v1 * sc; }
                    u32x4 w; w.x = cvt_pk_bf16(v0[0], v0[1]); w.y = cvt_pk_bf16(v0[2], v0[3]); w.z = cvt_pk_bf16(v1[0], v1[1]); w.w = cvt_pk_bf16(v1[2], v1[3]);
                    const int g64 = 4 * (pn & 1) + 2 * bj + (wc >> 1), cin = 32 * (wc & 1) + 8 * fq;
                    bf16_t* dst;
                    if (gate) dst = O + (size_t)6 * 512 * M_ROWS + row * 2048 + (pn - 12) * BM + bj * HALF + wc * 32 + 8 * fq;
                    else if (seg == 5) dst = O + (size_t)5 * 512 * M_ROWS + ((size_t)(g64 >> 1) * M_ROWS + row) * 128 + 64 * (g64 & 1) + cin;
                    else dst = O + (size_t)seg * 512 * M_ROWS + ((size_t)g64 * M_ROWS + row) * 64 + cin;
                    *(u32x4*)dst = w; } }
        if (pn < 4) {
            float mx[2] = {0.f, 0.f};
#pragma unroll
            for (int ai = 0; ai < 2; ++ai)
#pragma unroll
                for (int m = 0; m < 4; ++m)
#pragma unroll
                    for (int bj = 0; bj < 2; ++bj) { const f32x4 v0 = acc[ai][bj][m][0] * sc, v1 = acc[ai][bj][m][1] * sc;
                        float ss = (v0[0] * v0[0] + v0[1] * v0[1]) + (v0[2] * v0[2] + v0[3] * v0[3]) + (v1[0] * v1[0] + v1[1] * v1[1]) + (v1[2] * v1[2] + v1[3] * v1[3]);
                        ss += shx(ss, 16); ss += shx(ss, 32); mx[bj] = fmaxf(mx[bj], ss); }
#pragma unroll
            for (int bj = 0; bj < 2; ++bj) { float v = mx[bj]; v = fmaxf(v, shx(v, 1)); v = fmaxf(v, shx(v, 2)); v = fmaxf(v, shx(v, 4)); v = fmaxf(v, shx(v, 8));
                if (fr == 0 && fq == 0) atomicMax(nrm + (pn >> 1) * 16 + (4 * (pn & 1) + 2 * bj + (wc >> 1)) * 2 + (wc & 1), __float_as_uint(v)); }
        }
    }
};
struct EpiMerge {
    static constexpr bool PERM = true, AFTER_DRAIN = false;
    const bf16_t* proj; float* T; bf16_t* merged;
    __device__ __forceinline__ void operator()(const f32x4 (&acc)[2][2][4][2], const Unit& u, int wr, int wc, int fr, int fq) const {
        const bool second = u.pn >= 4; const int pn = second ? u.pn - 4 : u.pn, pm = second ? u.pm - 64 : u.pm;
        const int row0 = pm * BM + wr * 64 + fr, col0 = pn * BM + wc * 32 + 8 * fq; const int goff = second ? 1024 : 0;
#pragma unroll
        for (int ai = 0; ai < 2; ++ai)
#pragma unroll
            for (int m = 0; m < 4; ++m) { const size_t row = (size_t)(row0 + ai * HALF + m * 16);
#pragma unroll
                for (int bj = 0; bj < 2; ++bj) { const int col = col0 + bj * HALF;
                    const u32x4 gw = *(const u32x4*)(proj + (size_t)6 * 512 * M_ROWS + row * 2048 + goff + col);
                    const f32x4 g0 = (f32x4){bf_lo(gw.x), bf_hi(gw.x), bf_lo(gw.y), bf_hi(gw.y)}, g1 = (f32x4){bf_lo(gw.z), bf_hi(gw.z), bf_lo(gw.w), bf_hi(gw.w)};
                    f32x4 v0 = acc[ai][bj][m][0] * g0, v1 = acc[ai][bj][m][1] * g1; bf16_t* mp = merged + row * 1024 + col;
                    if (second) { const u32x4 tw = *(const u32x4*)mp;
                        v0 = v0 + (f32x4){bf_lo(tw.x), bf_hi(tw.x), bf_lo(tw.y), bf_hi(tw.y)}; v1 = v1 + (f32x4){bf_lo(tw.z), bf_hi(tw.z), bf_lo(tw.w), bf_hi(tw.w)}; }
                    u32x4 w; w.x = cvt_pk_bf16(v0[0], v0[1]); w.y = cvt_pk_bf16(v0[2], v0[3]); w.z = cvt_pk_bf16(v1[0], v1[1]); w.w = cvt_pk_bf16(v1[2], v1[3]);
                    *(u32x4*)mp = w; }
                asm volatile("" ::: "memory"); }
    }
};
struct PrevLN { const float* src; const float* stats; const float* g; const float* b; };
struct EpiResid {
    static constexpr bool PERM = false, AFTER_DRAIN = false;
    PrevLN p; float* z; float alpha; float sc;
    __device__ __forceinline__ void operator()(const f32x4 (&acc)[2][2][4][2], const Unit& u, int wr, int wc, int fr, int fq) const {
        int row0 = u.pm * BM + wr * 64 + fr, col0 = u.pn * BM + wc * 32 + 4 * fq; asm volatile("" : "+v"(row0), "+v"(col0));
        typedef float f32x2v __attribute__((ext_vector_type(2)));
#pragma unroll
        for (int ai = 0; ai < 2; ++ai)
#pragma unroll
            for (int m = 0; m < 4; ++m) { const int row = row0 + ai * HALF + m * 16; const size_t ro = (size_t)row * 1024 + col0; const f32x2v st = *(const f32x2v*)(p.stats + 2 * row);
#pragma unroll
                for (int bj = 0; bj < 2; ++bj)
#pragma unroll
                    for (int n = 0; n < 2; ++n) { const int c = col0 + bj * HALF + n * 16; const size_t off = ro + bj * HALF + n * 16;
                        const f32x4 sv = *(const f32x4*)(p.src + off), gv = *(const f32x4*)(p.g + c), bv = *(const f32x4*)(p.b + c);
                        const f32x4 hv = (sv - st.x) * st.y * gv + bv; *(f32x4*)(z + off) = hv * alpha + acc[ai][bj][m][n] * sc; }
                asm volatile("" ::: "memory"); }
    }
};
struct EpiSwiglu {
    static constexpr bool PERM = true, AFTER_DRAIN = false;
    bf16_t* O; int ldo; int nper; float isc;
    __device__ __forceinline__ void operator()(const f32x4 (&acc)[2][2][4][2], const Unit& u, int wr, int wc, int fr, int fq) const {
        const int pnl = u.pn % nper; const int row0 = u.pm * BM + wr * 64 + fr, col0 = pnl * HALF + wc * 32 + 8 * fq;
#pragma unroll
        for (int ai = 0; ai < 2; ++ai)
#pragma unroll
            for (int m = 0; m < 4; ++m) { const f32x4 g0 = acc[ai][0][m][0] * isc, g1 = acc[ai][0][m][1] * isc, u0 = acc[ai][1][m][0] * isc, u1 = acc[ai][1][m][1] * isc; float r[8];
#pragma unroll
                for (int i = 0; i < 4; ++i) { r[i] = g0[i] * sigm(g0[i]) * u0[i]; r[4 + i] = g1[i] * sigm(g1[i]) * u1[i]; }
                u32x4 w; w.x = cvt_pk_bf16(r[0], r[1]); w.y = cvt_pk_bf16(r[2], r[3]); w.z = cvt_pk_bf16(r[4], r[5]); w.w = cvt_pk_bf16(r[6], r[7]);
                *(u32x4*)(O + (size_t)(row0 + ai * HALF + m * 16) * ldo + col0) = w; }
    }
};
struct EpiSwiglu8 {
    static constexpr bool PERM = true, AFTER_DRAIN = false;
    unsigned char* O; int ldo; int nper; float isc, osc;
    __device__ __forceinline__ void operator()(const f32x4 (&acc)[2][2][4][2], const Unit& u, int wr, int wc, int fr, int fq) const {
        const int pnl = u.pn % nper; const int row0 = u.pm * BM + wr * 64 + fr, col0 = pnl * HALF + wc * 32 + 8 * fq;
#pragma unroll
        for (int ai = 0; ai < 2; ++ai)
#pragma unroll
            for (int m = 0; m < 4; ++m) { const f32x4 g0 = acc[ai][0][m][0] * isc, g1 = acc[ai][0][m][1] * isc, u0 = acc[ai][1][m][0] * isc, u1 = acc[ai][1][m][1] * isc; float r[8];
#pragma unroll
                for (int i = 0; i < 4; ++i) { r[i] = g0[i] * sigm(g0[i]) * u0[i] * osc; r[4 + i] = g1[i] * sigm(g1[i]) * u1[i] * osc; }
                int w0 = 0, w1 = 0; w0 = __builtin_amdgcn_cvt_pk_fp8_f32(r[0], r[1], w0, false); w0 = __builtin_amdgcn_cvt_pk_fp8_f32(r[2], r[3], w0, true);
                w1 = __builtin_amdgcn_cvt_pk_fp8_f32(r[4], r[5], w1, false); w1 = __builtin_amdgcn_cvt_pk_fp8_f32(r[6], r[7], w1, true);
                typedef unsigned u32x2 __attribute__((ext_vector_type(2)));
                *(u32x2*)(O + (size_t)(row0 + ai * HALF + m * 16) * ldo + col0) = (u32x2){(unsigned)w0, (unsigned)w1}; }
    }
};
struct EpiStoreF32 {
    static constexpr bool PERM = false, AFTER_DRAIN = false;
    float* O; int nper; float sc;
    __device__ __forceinline__ void operator()(const f32x4 (&acc)[2][2][4][2], const Unit& u, int wr, int wc, int fr, int fq) const {
        const int pnl = u.pn % nper; const int row0 = u.pm * BM + wr * 64 + fr, col0 = pnl * BM + wc * 32 + 4 * fq;
#pragma unroll
        for (int ai = 0; ai < 2; ++ai)
#pragma unroll
            for (int m = 0; m < 4; ++m) { const size_t ro = (size_t)(row0 + ai * HALF + m * 16) * 1024 + col0;
#pragma unroll
                for (int bj = 0; bj < 2; ++bj)
#pragma unroll
                    for (int n = 0; n < 2; ++n) *(f32x4*)(O + ro + bj * HALF + n * 16) = acc[ai][bj][m][n] * sc; }
    }
};
__device__ __forceinline__ void map_unit(int L, int nM, int nN, Unit& u) {
    const int nwg = nM * nN; int wgid = L; { const int q = nwg / NXCD, r = nwg % NXCD, xcd = wgid % NXCD, off = wgid / NXCD; wgid = (xcd < r ? xcd * (q + 1) : r * (q + 1) + (xcd - r) * q) + off; }
    const int nig = WGM * nN, gid = wgid / nig, fm = gid * WGM, gsz = (nM - fm) < WGM ? (nM - fm) : WGM;
    u.pm = fm + ((wgid % nig) % gsz); u.pn = (wgid % nig) / gsz;
}
__device__ __forceinline__ int main_units(int nwg, int G) { const int full = (nwg / G) * G, r = nwg - full; return (r > 0 && r <= G / 8 && full > 0) ? full : nwg; }
constexpr int TAIL_KS = 7, TAIL_K = 256;
typedef int i32x4 __attribute__((ext_vector_type(4)));
struct TableOrder {
    const i32x4* t; int n, G, c;
    __device__ bool next(int i, Unit& u) const { const int j = i * G + c; if (j >= n) return false; const i32x4 e = t[j]; u.pm = __builtin_amdgcn_readfirstlane(e.x); u.pn = __builtin_amdgcn_readfirstlane(e.y); u.koff = __builtin_amdgcn_readfirstlane(e.z); u.aux = __builtin_amdgcn_readfirstlane(e.w); return true; }
    __device__ __forceinline__ void a_ready(const Unit&) const {}
    __device__ __forceinline__ void done(const Unit&) const {}
};
struct EpiStoreTail {
    static constexpr bool PERM = false, AFTER_DRAIN = false;
    float* part; float sc;
    __device__ __forceinline__ void operator()(const f32x4 (&acc)[2][2][4][2], const Unit& u, int wr, int wc, int fr, int fq) const {
        float* base = part + (size_t)u.aux * 65536;
        int row0 = wr * 64 + fr, col0 = wc * 32 + 4 * fq; asm volatile("" : "+v"(row0), "+v"(col0));
#pragma unroll
        for (int ai = 0; ai < 2; ++ai)
#pragma unroll
            for (int m = 0; m < 4; ++m) { const size_t ro = (size_t)(row0 + ai * HALF + m * 16) * 256 + col0;
#pragma unroll
                for (int bj = 0; bj < 2; ++bj)
#pragma unroll
                    for (int n = 0; n < 2; ++n) *(f32x4*)(base + ro + bj * HALF + n * 16) = acc[ai][bj][m][n] * sc; }
    }
};
struct MergeOrder {
    StaticOrder b;
    __device__ bool next(int i, Unit& u) const { if (!b.next(i >> 1, u)) return false; if (i & 1) { u.pm += 64; u.pn += 4; } return true; }
    __device__ __forceinline__ void a_ready(const Unit&) const {}
    __device__ __forceinline__ void done(const Unit&) const {}
};
struct MoeOrder {
    StaticOrder b; const int* te; int nper;
    __device__ bool next(int i, Unit& u) const { if (!b.next(i, u)) return false; u.pn += __builtin_amdgcn_readfirstlane(te[u.pm]) * nper; return true; }
    __device__ __forceinline__ void a_ready(const Unit&) const {}
    __device__ __forceinline__ void done(const Unit&) const {}
};

typedef int i32x4v __attribute__((ext_vector_type(4)));
typedef int i32x8v __attribute__((ext_vector_type(8)));
template <class Epi, class Sched, bool ALIGN_EPI = false, bool SP2 = false, bool F8 = false>
__device__ __forceinline__ void gemm_phase(PG8_LAS unsigned char* lds, const Gemm g, const Sched& S, const Epi& E, const int wv) {
    const int tid = ::mk_tid(wv); const int wid = wv, lane = tid & 63, wr = wid >> 2, wc = wid & 3, fr = lane & 15, fq = lane >> 4;
    const int K = g.K, nt = K / BK, LD = g.ld ? g.ld : g.K;
    unsigned voffA[2], voffB[2];
#pragma unroll
    for (int i = 0; i < 2; ++i) { int R, C; stage_rc(tid * 16 + i * 8192, R, C); const int Rb = Epi::PERM ? ((R & ~31) + perm32(R & 31)) : R;
        voffA[i] = (unsigned)(R * LD + C) * 2u; voffB[i] = (unsigned)(Rb * LD + C) * 2u; }
    const unsigned kstep = (unsigned)(BK * 2);
    const unsigned hstep = (unsigned)HALF * LD * 2;
    const unsigned tstep = 2 * hstep;
    const unsigned ldsw = (unsigned)wid * 1024u;
    const int aoff = lds_byte(wr * 64 + fr, fq * 8), boff = lds_byte(wc * 32 + fr, fq * 8);
#define PG8_SA(b, h) (((b) * 2 + (h)) * HTB)
#define PG8_SB(b, h) ((4 + (b) * 2 + (h)) * HTB)
    const __amdgpu_buffer_rsrc_t rs_voffA = __builtin_amdgcn_make_buffer_rsrc((void*)g.A, 0, 0x7fffffff, 0x00020000);
    const __amdgpu_buffer_rsrc_t rs_voffB = __builtin_amdgcn_make_buffer_rsrc((void*)g.Bt, 0, 0x7fffffff, 0x00020000);
#define PG8_STAGE(bufoff, gbase, voff) do { _Pragma("unroll") for (int _i = 0; _i < 2; ++_i) \
        __builtin_amdgcn_raw_ptr_buffer_load_lds(rs_##voff, (PG8_LAS unsigned*)(lds + (bufoff) + ldsw + _i * 8192), 16, (int)(voff)[_i], (int)(gbase), 0, 0); } while (0)
#define PG8_LDA(dst, b, h) do { if constexpr (F8) { _Pragma("unroll") for (int m = 0; m < 4; ++m) dst##8[m] = __builtin_shufflevector(*(const PG8_LAS i32x4v*)(lds + PG8_SA(b, h) + aoff + m * 2048), *(const PG8_LAS i32x4v*)(lds + PG8_SA(b, h) + aoff + m * 2048 + 1024), 0, 1, 2, 3, 4, 5, 6, 7); } \
        else { _Pragma("unroll") for (int m = 0; m < 4; ++m) _Pragma("unroll") for (int k = 0; k < 2; ++k) dst[m][k] = *(const PG8_LAS bf16x8*)(lds + PG8_SA(b, h) + aoff + m * 2048 + k * 1024); } } while (0)
#define PG8_LDB(dst, b, h) do { if constexpr (F8) { _Pragma("unroll") for (int n = 0; n < 2; ++n) dst##8[n] = __builtin_shufflevector(*(const PG8_LAS i32x4v*)(lds + PG8_SB(b, h) + boff + n * 2048), *(const PG8_LAS i32x4v*)(lds + PG8_SB(b, h) + boff + n * 2048 + 1024), 0, 1, 2, 3, 4, 5, 6, 7); } \
        else { _Pragma("unroll") for (int n = 0; n < 2; ++n) _Pragma("unroll") for (int k = 0; k < 2; ++k) dst[n][k] = *(const PG8_LAS bf16x8*)(lds + PG8_SB(b, h) + boff + n * 2048 + k * 1024); } } while (0)
#define PG8_MMA(ai, bj, At, Bt) do { __builtin_amdgcn_s_setprio(1); _Pragma("unroll") for (int m = 0; m < 4; ++m) _Pragma("unroll") for (int n = 0; n < 2; ++n) { \
        if constexpr (F8) { acc[ai][bj][m][n] = __builtin_amdgcn_mfma_scale_f32_16x16x128_f8f6f4(Bt##8[n], At##8[m], acc[ai][bj][m][n], 0, 0, 0, 0, 0, 0); } \
        else { _Pragma("unroll") for (int k = 0; k < 2; ++k) acc[ai][bj][m][n] = __builtin_amdgcn_mfma_f32_16x16x32_bf16(Bt[n][k], At[m][k], acc[ai][bj][m][n], 0, 0, 0); } } __builtin_amdgcn_s_setprio(0); } while (0)
#define PG8_WAIT_V(n) asm volatile("s_waitcnt vmcnt(" #n ")" ::: "memory")
#define PG8_WAIT_L(n) asm volatile("s_waitcnt lgkmcnt(" #n ")" ::: "memory")
#define PG8_BAR __builtin_amdgcn_s_barrier()
#define PG8_SCHED __builtin_amdgcn_sched_barrier(0)
    Unit cur, nxt; int ui = 0;
    if (!S.next(0, cur)) return;
    f32x4 acc[2][2][4][2];
#pragma unroll
    for (int a = 0; a < 2; ++a)
#pragma unroll
        for (int b = 0; b < 2; ++b)
#pragma unroll
            for (int m = 0; m < 4; ++m)
#pragma unroll
                for (int n = 0; n < 2; ++n) acc[a][b][m][n] = (f32x4){0.f, 0.f, 0.f, 0.f};
    bf16x8 At[4][2], B0[2][2], B1[2][2];
    i32x8v At8[4], B08[2], B18[2];
    unsigned cA = (unsigned)cur.pm * tstep + (unsigned)cur.koff * 2u, cB = (unsigned)cur.pn * tstep + (unsigned)cur.koff * 2u;
    S.a_ready(cur);
    if constexpr (SP2) {
        PG8_STAGE(PG8_SB(0, 0), cB, voffB); PG8_STAGE(PG8_SB(0, 1), cB + hstep, voffB); PG8_STAGE(PG8_SA(0, 0), cA, voffA); PG8_STAGE(PG8_SA(0, 1), cA + hstep, voffA);
        if (wr == 1) PG8_BAR;
        PG8_WAIT_V(2); PG8_BAR;
        PG8_STAGE(PG8_SB(1, 0), cB + kstep, voffB); PG8_STAGE(PG8_SA(1, 0), cA + kstep, voffA); PG8_STAGE(PG8_SB(1, 1), cB + hstep + kstep, voffB);
        PG8_WAIT_V(6); PG8_BAR;
    } else {
        PG8_STAGE(PG8_SB(0, 0), cB, voffB); PG8_STAGE(PG8_SA(0, 0), cA, voffA); PG8_STAGE(PG8_SB(0, 1), cB + hstep, voffB); PG8_STAGE(PG8_SA(0, 1), cA + hstep, voffA);
        if (wr == 1) PG8_BAR;
        PG8_WAIT_V(4); PG8_BAR;
        PG8_STAGE(PG8_SB(1, 0), cB + kstep, voffB); PG8_STAGE(PG8_SA(1, 0), cA + kstep, voffA); PG8_STAGE(PG8_SB(1, 1), cB + hstep + kstep, voffB);
        PG8_WAIT_V(6); PG8_BAR;
    }
    _Pragma("clang loop unroll(disable)")
    for (;;) {
        const bool has_next = S.next(ui + 1, nxt);
        const unsigned nA = has_next ? (unsigned)nxt.pm * tstep + (unsigned)nxt.koff * 2u : cA, nB = has_next ? (unsigned)nxt.pn * tstep + (unsigned)nxt.koff * 2u : cB;
        _Pragma("clang loop unroll(disable)")
        for (int t = 0; t < nt; t += 2) {
            const bool last = (t == nt - 2);
            const unsigned a1 = cA + (unsigned)(t + 1) * kstep;
            const unsigned a2 = last ? nA : cA + (unsigned)(t + 2) * kstep, b2 = last ? nB : cB + (unsigned)(t + 2) * kstep;
            const unsigned a3 = a2 + kstep, b3 = b2 + kstep;
            if (last && has_next) S.a_ready(nxt);
            if constexpr (SP2) {
            PG8_LDB(B0, 0, 0); PG8_LDB(B1, 0, 1); PG8_SCHED; PG8_LDA(At, 0, 0); PG8_STAGE(PG8_SA(1, 1), a1 + hstep, voffA);
            PG8_WAIT_V(8); PG8_WAIT_L(0); PG8_BAR; PG8_MMA(0, 0, At, B0); PG8_MMA(0, 1, At, B1); PG8_BAR; PG8_SCHED;
            PG8_LDA(At, 0, 1); PG8_STAGE(PG8_SB(0, 0), b2, voffB); PG8_STAGE(PG8_SB(0, 1), b2 + hstep, voffB); PG8_STAGE(PG8_SA(0, 0), a2, voffA);
            PG8_WAIT_V(8); PG8_WAIT_L(0); PG8_BAR; PG8_MMA(1, 0, At, B0); PG8_MMA(1, 1, At, B1); PG8_BAR; PG8_SCHED;
            PG8_LDB(B0, 1, 0); PG8_LDB(B1, 1, 1); PG8_SCHED; PG8_LDA(At, 1, 0); PG8_STAGE(PG8_SA(0, 1), a2 + hstep, voffA);
            PG8_WAIT_V(8); PG8_WAIT_L(0); PG8_BAR; PG8_MMA(0, 0, At, B0); PG8_MMA(0, 1, At, B1); PG8_BAR; PG8_SCHED;
            PG8_LDA(At, 1, 1); PG8_STAGE(PG8_SB(1, 0), b3, voffB); PG8_STAGE(PG8_SB(1, 1), b3 + hstep, voffB); PG8_STAGE(PG8_SA(1, 0), a3, voffA);
            PG8_WAIT_V(8); PG8_WAIT_L(0); PG8_BAR; PG8_MMA(1, 0, At, B0); PG8_MMA(1, 1, At, B1); PG8_BAR; PG8_SCHED;
            } else {
            PG8_LDB(B0, 0, 0); PG8_SCHED; PG8_LDA(At, 0, 0); PG8_STAGE(PG8_SA(1, 1), a1 + hstep, voffA);
            PG8_WAIT_L(8); PG8_BAR; PG8_WAIT_L(0); PG8_MMA(0, 0, At, B0); PG8_BAR; PG8_SCHED;
            PG8_LDB(B1, 0, 1); PG8_STAGE(PG8_SB(0, 0), b2, voffB);
            PG8_BAR; PG8_WAIT_L(0); PG8_MMA(0, 1, At, B1); PG8_BAR;
            PG8_LDA(At, 0, 1); PG8_STAGE(PG8_SA(0, 0), a2, voffA);
            PG8_BAR; PG8_WAIT_L(0); PG8_MMA(1, 0, At, B0); PG8_BAR; PG8_SCHED;
            PG8_STAGE(PG8_SB(0, 1), b2 + hstep, voffB);
            PG8_WAIT_V(6); PG8_BAR; PG8_MMA(1, 1, At, B1); PG8_BAR;
            PG8_LDB(B0, 1, 0); PG8_SCHED; PG8_LDA(At, 1, 0); PG8_STAGE(PG8_SA(0, 1), a2 + hstep, voffA);
            PG8_WAIT_L(8); PG8_BAR; PG8_WAIT_L(0); PG8_MMA(0, 0, At, B0); PG8_BAR; PG8_SCHED;
            PG8_LDB(B1, 1, 1); PG8_STAGE(PG8_SB(1, 0), b3, voffB);
            PG8_BAR; PG8_WAIT_L(0); PG8_MMA(0, 1, At, B1); PG8_BAR;
            PG8_LDA(At, 1, 1); PG8_STAGE(PG8_SA(1, 0), a3, voffA);
            PG8_BAR; PG8_WAIT_L(0); PG8_MMA(1, 0, At, B0); PG8_BAR; PG8_SCHED;
            PG8_STAGE(PG8_SB(1, 1), b3 + hstep, voffB);
            PG8_WAIT_V(6); PG8_BAR; PG8_MMA(1, 1, At, B1); PG8_BAR;
            }
        }
        if constexpr (ALIGN_EPI) { if (wr == 0) PG8_BAR; }
        if constexpr (!Epi::AFTER_DRAIN) { const int t2_ = ::mk_tid(wv); const int l2_ = t2_ & 63;
            E(acc, cur, wr, wc, l2_ & 15, l2_ >> 4); S.done(cur); }
        if (!has_next) break;
#pragma unroll
        for (int a = 0; a < 2; ++a)
#pragma unroll
            for (int b = 0; b < 2; ++b)
#pragma unroll
                for (int m = 0; m < 4; ++m)
#pragma unroll
                    for (int n = 0; n < 2; ++n) acc[a][b][m][n] = (f32x4){0.f, 0.f, 0.f, 0.f};
        cur = nxt; cA = nA; cB = nB; ++ui;
        if constexpr (ALIGN_EPI) { if (wr == 1) PG8_BAR; }
    }
    PG8_WAIT_V(0);
    if constexpr (!ALIGN_EPI) { if (wr == 0) PG8_BAR; }
    PG8_BAR;
    if constexpr (Epi::AFTER_DRAIN) { E.fused(acc, cur, wr, wc, fr, fq, lds, wid, lane); S.done(cur); }
#undef PG8_SA
#undef PG8_SB
#undef PG8_STAGE
#undef PG8_LDA
#undef PG8_LDB
#undef PG8_MMA
#undef PG8_WAIT_V
#undef PG8_WAIT_L
#undef PG8_BAR
#undef PG8_SCHED
}
}
namespace attn_body {
#ifdef NOBIAS
constexpr bool NOBIAS_=true;
#else
constexpr bool NOBIAS_=false;
#endif
using bf16=__hip_bfloat16;
using bf16x8=__attribute__((ext_vector_type(8)))short;
using s16x4=__attribute__((ext_vector_type(4)))short;
using f32x16=__attribute__((ext_vector_type(16)))float;
using u32x4=__attribute__((ext_vector_type(4)))unsigned;
constexpr int SEQ=16384,D=64,PITCH=64,OPITCH=512;
constexpr int NW=8,QBLK=32,QB=QBLK*NW,KVBLK=64,NQB=SEQ/QB;
__device__ __forceinline__ int crow(int r,int hi){return (r&3)+8*(r>>2)+4*hi;}
#define SBAR() __builtin_amdgcn_sched_barrier(0)
__device__ __forceinline__ void cmask(f32x16&p0,f32x16&p1,int jb,int qrel,int hi){
  const float NEG=-INFINITY; int kb=64*jb+4*hi;
  #pragma unroll
  for(int r=0;r<16;++r){int kv=kb+(r&3)+8*(r>>2); if(kv>qrel)p0[r]=NEG; if(kv+32>qrel)p1[r]=NEG;}
}

typedef float f32x4a __attribute__((ext_vector_type(4)));
__device__ __forceinline__ void biasf(f32x16&p0,f32x16&p1,const __attribute__((address_space(3))) float*p){
  #pragma unroll
  for(int j=0;j<4;++j){ const f32x4a a=*(const __attribute__((address_space(3))) f32x4a*)(p+8*j), b=*(const __attribute__((address_space(3))) f32x4a*)(p+32+8*j);
    p0[4*j]+=a[0];p0[4*j+1]+=a[1];p0[4*j+2]+=a[2];p0[4*j+3]+=a[3]; p1[4*j]+=b[0];p1[4*j+1]+=b[1];p1[4*j+2]+=b[2];p1[4*j+3]+=b[3];
    asm volatile("":"+v"(p0),"+v"(p1)); __builtin_amdgcn_sched_barrier(0); }
}
__device__ __forceinline__ void biasd(f32x16&p0,f32x16&p1,const __attribute__((address_space(3))) float*lut,int base){
  #pragma unroll
  for(int r=0;r<16;++r){ const int d0=base-((r&3)+8*(r>>2)); unsigned i0=(unsigned)d0; i0=i0>127u?127u:i0; unsigned i1=(unsigned)(d0-32); i1=i1>127u?127u:i1; p0[r]+=lut[i0]; p1[r]+=lut[i1];
    if((r&3)==3){ asm volatile("":"+v"(p0),"+v"(p1)); __builtin_amdgcn_sched_barrier(0); } }
}
typedef float f32x2a __attribute__((ext_vector_type(2)));
__device__ __forceinline__ void submh(f32x16&p0,f32x16&p1,float mh){ const f32x2a m2={mh,mh};
  #pragma unroll
  for(int r=0;r<16;r+=2){ f32x2a a={p0[r],p0[r+1]}, b={p1[r],p1[r+1]}; a=a-m2; b=b-m2; p0[r]=a[0];p0[r+1]=a[1];p1[r]=b[0];p1[r+1]=b[1]; }
}
constexpr int NSLOT=3, SLOTB=8192;
constexpr int LDS_K=0, LDS_V=NSLOT*SLOTB, LDS_WS=2*NSLOT*SLOTB, LDS_OST=LDS_WS+NW*64*4, LDS_KB=LDS_OST+NW*4096, LDS_CNT=LDS_KB+SEQ*4, LDS_BYTES=LDS_CNT+64;
constexpr float C2=0.125f*1.4426950408889634f;
__device__ __forceinline__ void glds16(const void*gsrc,unsigned lds_dst){unsigned keep;
  asm volatile("s_mov_b32 %0, m0\n\ts_mov_b32 m0, %2\n\ts_nop 0\n\tglobal_load_lds_dwordx4 %1, off\n\ts_mov_b32 m0, %0":"=&s"(keep):"v"(gsrc),"s"(lds_dst):"memory");}
typedef int rsrc4 __attribute__((ext_vector_type(4)));
__device__ __forceinline__ rsrc4 mk_rsrc(const void*p){ const unsigned long long a=(unsigned long long)(uintptr_t)p; rsrc4 r; r.x=(int)(unsigned)a; r.y=(int)((unsigned)(a>>32)&0xffffu); r.z=0x7fffffff; r.w=0x00020000; return r; }
__device__ __forceinline__ void bglds16(rsrc4 rs,unsigned voff,unsigned soff,unsigned lds_dst){unsigned keep;
  asm volatile("s_mov_b32 %0, m0\n\ts_mov_b32 m0, %2\n\ts_nop 0\n\tbuffer_load_dwordx4 %1, %3, %4 offen lds\n\ts_mov_b32 m0, %0":"=&s"(keep):"v"(voff),"s"(lds_dst),"s"(rs),"s"(soff):"memory");}
__device__ __forceinline__ float max3f(float a,float b,float c){float r;asm("v_max3_f32 %0, %1, %2, %3":"=v"(r):"v"(a),"v"(b),"v"(c));return r;}
__device__ __forceinline__ float max2f(float a,float b){float r;asm("v_max_f32_e32 %0, %1, %2":"=v"(r):"v"(a),"v"(b));return r;}
__device__ __forceinline__ float fadd_s(float a,float b){float r;asm("v_add_f32_e32 %0, %1, %2":"=v"(r):"v"(a),"v"(b));return r;}
__device__ __forceinline__ float fsub_s(float a,float b){float r;asm("v_sub_f32_e32 %0, %1, %2":"=v"(r):"v"(a),"v"(b));return r;}
typedef float f32x2_t __attribute__((ext_vector_type(2))); typedef __bf16 bf16x2_t __attribute__((ext_vector_type(2)));
__device__ __forceinline__ unsigned cvtpk_s(float lo,float hi){f32x2_t v={lo,hi};bf16x2_t b=__builtin_convertvector(v,bf16x2_t);return __builtin_bit_cast(unsigned,b);}
#define WAIT_BAR(N) asm volatile("s_waitcnt vmcnt(" #N ") lgkmcnt(0)\n\ts_barrier":::"memory")

__device__ __forceinline__ void qkt(f32x16&p0,f32x16&p1,const char*Kslot,const bf16x8*qr,const f32x16&negm,int r32,int hi){
  const char*kb=Kslot+hi*1024+r32*16;
  #pragma unroll
  for(int d0=0;d0<4;++d0){
    const bf16x8 b0=*reinterpret_cast<const bf16x8*>(kb+d0*2048);
    const bf16x8 b1=*reinterpret_cast<const bf16x8*>(kb+d0*2048+512);
    if(d0==0){p0=__builtin_amdgcn_mfma_f32_32x32x16_bf16(b0,qr[0],negm,0,0,0);p1=__builtin_amdgcn_mfma_f32_32x32x16_bf16(b1,qr[0],negm,0,0,0);}
    else{p0=__builtin_amdgcn_mfma_f32_32x32x16_bf16(b0,qr[d0],p0,0,0,0);p1=__builtin_amdgcn_mfma_f32_32x32x16_bf16(b1,qr[d0],p1,0,0,0);}}
}
typedef __attribute__((address_space(3))) const char* lds_cptr;
typedef short v4i16_t __attribute__((ext_vector_type(4)));
__device__ __forceinline__ void kload8(bf16x8*kf,lds_cptr kp){
  kf[0]=*(const __attribute__((address_space(3))) bf16x8*)(kp);      kf[1]=*(const __attribute__((address_space(3))) bf16x8*)(kp+512);
  kf[2]=*(const __attribute__((address_space(3))) bf16x8*)(kp+2048); kf[3]=*(const __attribute__((address_space(3))) bf16x8*)(kp+2560);
  kf[4]=*(const __attribute__((address_space(3))) bf16x8*)(kp+4096); kf[5]=*(const __attribute__((address_space(3))) bf16x8*)(kp+4608);
  kf[6]=*(const __attribute__((address_space(3))) bf16x8*)(kp+6144); kf[7]=*(const __attribute__((address_space(3))) bf16x8*)(kp+6656);
}
__device__ __forceinline__ void kload2(bf16x8*kf,lds_cptr kp,int j){ kf[2*j]=*(const __attribute__((address_space(3))) bf16x8*)(kp+j*2048); kf[2*j+1]=*(const __attribute__((address_space(3))) bf16x8*)(kp+j*2048+512); }
__device__ __forceinline__ s16x4 vtr(lds_cptr p){ return __builtin_bit_cast(s16x4,__builtin_amdgcn_ds_read_tr16_b64_v4i16((__attribute__((address_space(3))) v4i16_t*)p)); }
__device__ __forceinline__ float rowmax(const f32x16&p0,const f32x16&p1){
  float a=max3f(p0[0],p0[1],p1[0]),b=max3f(p0[2],p0[3],p1[1]);a=max3f(a,p1[2],p1[3]);
  #pragma unroll
  for(int r=4;r<16;r+=4){a=max3f(a,p0[r],p0[r+1]);b=max3f(b,p0[r+2],p0[r+3]);a=max3f(a,p1[r],p1[r+1]);b=max3f(b,p1[r+2],p1[r+3]);}
  const float m=max2f(a,b);
  auto rr=__builtin_amdgcn_permlane32_swap(__float_as_uint(m),__float_as_uint(m),false,false);
  return max2f(__uint_as_float(rr[0]),__uint_as_float(rr[1]));
}
__device__ __forceinline__ void pv(f32x16*o,int vb,bf16x8 pa0,bf16x8 pa1,bf16x8 pa2,bf16x8 pa3){
  #pragma unroll
  for(int d0=0;d0<2;++d0){s16x4 lo[4],hi[4];
    #pragma unroll
    for(int ks=0;ks<4;++ks){
      asm volatile("ds_read_b64_tr_b16 %0,%1 offset:%c2":"=&v"(lo[ks]):"v"(vb),"i"(d0*4096+ks*1024):"memory");
      asm volatile("ds_read_b64_tr_b16 %0,%1 offset:%c2":"=&v"(hi[ks]):"v"(vb),"i"(d0*4096+ks*1024+512):"memory");}
    asm volatile("s_waitcnt lgkmcnt(0)":::"memory");SBAR();
    #define PK(k) (bf16x8){lo[k][0],lo[k][1],lo[k][2],lo[k][3],hi[k][0],hi[k][1],hi[k][2],hi[k][3]}
    o[d0]=__builtin_amdgcn_mfma_f32_32x32x16_bf16(pa0,PK(0),o[d0],0,0,0);
    o[d0]=__builtin_amdgcn_mfma_f32_32x32x16_bf16(pa1,PK(1),o[d0],0,0,0);
    o[d0]=__builtin_amdgcn_mfma_f32_32x32x16_bf16(pa2,PK(2),o[d0],0,0,0);
    o[d0]=__builtin_amdgcn_mfma_f32_32x32x16_bf16(pa3,PK(3),o[d0],0,0,0);
    #undef PK
  }
}

#ifndef ATTN_STORE16
#define ATTN_STORE16(p,v) (*(u32x4*)(p)=(v))
#endif
template<int MODE,int THRL> __device__ __forceinline__ void attn_unit(int qb,const bf16*Q,const bf16*__restrict__ K,const bf16*__restrict__ V,bf16*O,const float*__restrict__ cum,const float*__restrict__ relb,const float thr,char*shm,const int wv){
  const int tid=::mk_tid(wv); const int lane=tid&63,r32=lane&31,hi=lane>>5; const int wid=wv;
  const int q0=qb*QB;
  const bf16*Qw=Q+(long)(q0+wid*QBLK)*PITCH;
  typedef __attribute__((address_space(3))) float* lds_fptr;
  const lds_fptr kb3=(lds_fptr)(__attribute__((address_space(3))) char*)shm+LDS_KB/4;
  if constexpr(MODE==0){ const float cref=cum[q0]; for(int i=tid;i<q0+QB;i+=NW*64)kb3[i]=(cref-cum[i])*1.4426950408889634f; }
  int tskip=0;
  if constexpr(MODE==0){
    asm volatile("s_waitcnt lgkmcnt(0)\n\ts_barrier":::"memory");
    const int ntf=(q0+QB)/KVBLK; const int c=(tid<ntf)?(kb3[64*tid+63]<=-thr?1:0):0;
    const int cnt=__popcll(__ballot(c));
    const __attribute__((address_space(3))) int* cw=(const __attribute__((address_space(3))) int*)((__attribute__((address_space(3))) char*)shm+LDS_CNT);
    if(lane==0)((__attribute__((address_space(3))) int*)cw)[wid]=cnt;
    asm volatile("s_waitcnt lgkmcnt(0)\n\ts_barrier":::"memory");
    tskip=(cw[0]+cw[1]+cw[2]+cw[3])&~1; tskip=__builtin_amdgcn_readfirstlane(tskip);
  }
  else { if(tid<128){ int bk=tid; if(tid>=16){ bk=16+(int)(__logf((float)tid*(1.f/16.f))/2.0794415416798357f*16.f); bk=bk>31?31:bk; } kb3[tid]=(relb[bk*4]-relb[31*4])*1.4426950408889634f; } }
  const unsigned lds0=(unsigned)(uintptr_t)shm;
  float*wsf=(float*)(shm+LDS_WS)+wid*64;
  const bf16*Kh=K+(long)tskip*KVBLK*PITCH,*Vh=V+(long)tskip*KVBLK*PITCH; const lds_fptr kbt=kb3+64*tskip;
  const bf16*ksrc=Kh+(long)lane*PITCH+wid*8;
  const bf16*vsrc=Vh+(long)(16*(wid&3)+(lane>>2))*PITCH+(wid>>2)*32+(lane&3)*8;
  const unsigned kdst=lds0+LDS_K+wid*1024, vdst=lds0+LDS_V+wid*1024;
  #define DMA_K(t,slot) glds16(ksrc+(long)(t)*KVBLK*PITCH,(unsigned)__builtin_amdgcn_readfirstlane(kdst+(slot)))
  #define DMA_V(t,slot) glds16(vsrc+(long)(t)*KVBLK*PITCH,(unsigned)__builtin_amdgcn_readfirstlane(vdst+(slot)))
  const int vb0=(int)(lds0+LDS_V)+((lane>>4)&1)*32+(lane&3)*8+(4*hi+((lane&15)>>2))*64;
  const char*Kbase=shm+LDS_K; bf16x8 kf[8];
  const lds_cptr shm3=(lds_cptr)shm; const lds_cptr kp0=shm3+LDS_K+hi*1024+r32*16; const lds_cptr vp0=shm3+LDS_V+((lane>>4)&1)*32+(lane&3)*8+(4*hi+((lane&15)>>2))*64;
  const int NT=(q0+QB)/KVBLK-tskip;
  DMA_K(0,0);DMA_V(0,0);DMA_K(1,SLOTB);
  bf16x8 qr[4];
  #pragma unroll
  for(int d0=0;d0<4;++d0)qr[d0]=*reinterpret_cast<const bf16x8*>(&Qw[(long)r32*PITCH+d0*16+hi*8]);
  float mhat=0.f,l_reg=0.f;f32x16 o[2];o[0]=f32x16{};o[1]=f32x16{};const f32x16 z16=f32x16{};
  const int qrel=wid*QBLK+r32;
  #define CMASK(P0,P1,t) do{int jb_=(t)-(NT-4); if(jb_>=0)cmask(P0,P1,jb_,qrel,hi);}while(0)
  #define BIAS(P0,P1,t) do{ if constexpr(NOBIAS_) {} else if constexpr(MODE==0){ biasf(P0,P1,kbt+(64*(t)+4*hi)); } else { biasd(P0,P1,kb3,qrel-64*((t)-(NT-4))-4*hi); } }while(0)
  bool resc=false;
  #define START(P0,P1) do{ const float rm=rowmax(P0,P1); resc=false; \
    { const float dl=rm; mhat=fadd_s(mhat,dl); \
      _Pragma("unroll") for(int r=0;r<16;++r){P0[r]=fsub_s(P0[r],dl);P1[r]=fsub_s(P1[r],dl);} \
      } \
    _Pragma("unroll") for(int r=0;r<16;++r)P0[r]=__builtin_amdgcn_exp2f(P0[r]); }while(0)
  #define RESC() do{ if(resc){ asm volatile("s_waitcnt lgkmcnt(0)":::"memory"); \
      _Pragma("unroll") for(int d_=0;d_<2;++d_) _Pragma("unroll") for(int r=0;r<16;++r)o[d_][r]*=wsf[crow(r,hi)]; } }while(0)
  f32x16 pA0,pA1,pB0,pB1;
  int sl_prev=0,sl_cur=0,sl_next=SLOTB;
  #define ROT() do{sl_prev=sl_cur;sl_cur=sl_next;sl_next=(sl_next==(NSLOT-1)*SLOTB)?0:sl_next+SLOTB;}while(0)
  DMA_K(2,2*SLOTB);
  WAIT_BAR(3);
  qkt(pA0,pA1,Kbase,qr,z16,r32,hi);asm volatile("s_nop 15\n\ts_nop 7":"+v"(pA0),"+v"(pA1));BIAS(pA0,pA1,0);CMASK(pA0,pA1,0);
  START(pA0,pA1);
  _Pragma("unroll") for(int r=0;r<16;++r)pA1[r]=__builtin_amdgcn_exp2f(pA1[r]);
  WAIT_BAR(0);
  DMA_K(3,0);DMA_V(1,SLOTB);
  ROT();
  kload8(kf,kp0+sl_cur);
  WAIT_BAR(2);
  s16x4 vlo[8],vhi[8]; u32x4 pw0,pw1,pw2,pw3;
  #define PKW(P,B) cvtpk_s(P[B],P[B+1])
  #define PAF(k) __builtin_bit_cast(bf16x8,pw##k)
  #define VFR(i) (bf16x8){vlo[i][0],vlo[i][1],vlo[i][2],vlo[i][3],vhi[i][0],vhi[i][1],vhi[i][2],vhi[i][3]}
  #define PIN(x) asm volatile("":"+v"(x))
  #define MX3(a,b,c) __builtin_fmaxf(__builtin_fmaxf((a),(b)),(c))
  #define GAPA(MF,A0,A1,A2,A3,W0,W1,PW) do{ MF; sacc+=A0; sacc+=A1; sacc+=A2; sacc+=A3; PIN(sacc); W0; W1; PIN(PW); SBAR(); }while(0)
  #define EX(v) __builtin_amdgcn_exp2f(v)
  #define GAPB(MF,X,B) do{ MF; X[B]=EX(X[B]); X[B+1]=EX(X[B+1]); X[B+2]=EX(X[B+2]); X[B+3]=EX(X[B+3]); PIN(X); SBAR(); }while(0)
  #define VRD(i) do{ vlo[i]=vtr(vp_+(((i)>>2)*4096+((i)&3)*1024)); vhi[i]=vtr(vp_+(((i)>>2)*4096+((i)&3)*1024+512)); }while(0)
  #define KRD(G,j) do{ if(G){ kload2(kf,kp0+sl_next,j); SBAR(); } }while(0)
  #define STEP(C0,C1,P0,P1,t,GK,GV,GL) do{ SBAR(); \
    const lds_cptr vp_=vp0+sl_prev; \
    VRD(0); SBAR(); float sacc=(P0[0]+P0[1]); \
    GAPA(C0=__builtin_amdgcn_mfma_f32_32x32x16_bf16(kf[0],qr[0],z16,0,0,0), P0[2],P0[3],P0[4],P0[5],     pw0[0]=PKW(P0,0), pw0[1]=PKW(P0,2), pw0); \
    VRD(4); SBAR(); GAPA(C1=__builtin_amdgcn_mfma_f32_32x32x16_bf16(kf[1],qr[0],z16,0,0,0), P0[6],P0[7],P0[8],P0[9],     pw0[2]=PKW(P0,4), pw0[3]=PKW(P0,6), pw0); \
    VRD(1); SBAR(); GAPA(C0=__builtin_amdgcn_mfma_f32_32x32x16_bf16(kf[2],qr[1],C0,0,0,0),   P0[10],P0[11],P0[12],P0[13], pw1[0]=PKW(P0,8), pw1[1]=PKW(P0,10), pw1); \
    VRD(5); SBAR(); GAPA(C1=__builtin_amdgcn_mfma_f32_32x32x16_bf16(kf[3],qr[1],C1,0,0,0),   P0[14],P0[15],P1[0],P1[1],   pw1[2]=PKW(P0,12),pw1[3]=PKW(P0,14), pw1); \
    VRD(2); SBAR(); GAPA(C0=__builtin_amdgcn_mfma_f32_32x32x16_bf16(kf[4],qr[2],C0,0,0,0),   P1[2],P1[3],P1[4],P1[5],     pw2[0]=PKW(P1,0), pw2[1]=PKW(P1,2), pw2); \
    VRD(6); SBAR(); GAPA(C1=__builtin_amdgcn_mfma_f32_32x32x16_bf16(kf[5],qr[2],C1,0,0,0),   P1[6],P1[7],P1[8],P1[9],     pw2[2]=PKW(P1,4), pw2[3]=PKW(P1,6), pw2); \
    VRD(3); SBAR(); GAPA(C0=__builtin_amdgcn_mfma_f32_32x32x16_bf16(kf[6],qr[3],C0,0,0,0),   P1[10],P1[11],P1[12],P1[13], pw3[0]=PKW(P1,8), pw3[1]=PKW(P1,10), pw3); \
    VRD(7); SBAR(); GAPA(C1=__builtin_amdgcn_mfma_f32_32x32x16_bf16(kf[7],qr[3],C1,0,0,0),   P1[14],P1[15],0.f,0.f,       pw3[2]=PKW(P1,12),pw3[3]=PKW(P1,14), pw3); \
    l_reg+=sacc; \
    if(GK){DMA_K((t)+3,sl_cur);} if(GV){DMA_V((t)+1,sl_next);} \
    BIAS(C0,C1,t); CMASK(C0,C1,t); submh(C0,C1,mhat); \
    { float a=MX3(C0[0],C0[1],C1[0]),b=MX3(C0[2],C0[3],C1[1]); a=MX3(a,C1[2],C1[3]); \
      _Pragma("unroll") for(int r=4;r<16;r+=4){a=MX3(a,C0[r],C0[r+1]);b=MX3(b,C0[r+2],C0[r+3]);a=MX3(a,C1[r],C1[r+1]);b=MX3(b,C1[r+2],C1[r+3]);} \
      float rm=__builtin_fmaxf(a,b); { auto rr=__builtin_amdgcn_permlane32_swap(__float_as_uint(rm),__float_as_uint(rm),false,false); rm=__builtin_fmaxf(__uint_as_float(rr[0]),__uint_as_float(rr[1])); } \
      resc=false; \
      if(__builtin_expect(__any(rm>(float)THRL),0)){ const float dl=__builtin_fmaxf(rm,0.f); mhat+=dl; \
        _Pragma("unroll") for(int r=0;r<16;++r){C0[r]-=dl;C1[r]-=dl;} \
        const float f=__builtin_amdgcn_exp2f(-dl); l_reg*=f; if(hi==0)wsf[r32]=f; resc=true; } } \
    SBAR(); \
    GAPB(o[0]=__builtin_amdgcn_mfma_f32_32x32x16_bf16(PAF(0),VFR(0),o[0],0,0,0), C0,0); \
    GAPB(o[1]=__builtin_amdgcn_mfma_f32_32x32x16_bf16(PAF(0),VFR(4),o[1],0,0,0), C0,4); \
    KRD(GL,0); GAPB(o[0]=__builtin_amdgcn_mfma_f32_32x32x16_bf16(PAF(1),VFR(1),o[0],0,0,0), C0,8); \
    KRD(GL,1); GAPB(o[1]=__builtin_amdgcn_mfma_f32_32x32x16_bf16(PAF(1),VFR(5),o[1],0,0,0), C0,12); \
    KRD(GL,2); GAPB(o[0]=__builtin_amdgcn_mfma_f32_32x32x16_bf16(PAF(2),VFR(2),o[0],0,0,0), C1,0); \
    KRD(GL,3); GAPB(o[1]=__builtin_amdgcn_mfma_f32_32x32x16_bf16(PAF(2),VFR(6),o[1],0,0,0), C1,4); \
    GAPB(o[0]=__builtin_amdgcn_mfma_f32_32x32x16_bf16(PAF(3),VFR(3),o[0],0,0,0), C1,8); \
    GAPB(o[1]=__builtin_amdgcn_mfma_f32_32x32x16_bf16(PAF(3),VFR(7),o[1],0,0,0), C1,12); \
    }while(0)
  int t=1;
  #undef CMASK
  #define CMASK(P0,P1,t) do{}while(0)
  #undef BIAS
  #define BIAS(P0,P1,t) do{ if constexpr(NOBIAS_) {} else if constexpr(MODE==0){ biasf(P0,P1,kbt+(64*(t)+4*hi)); } }while(0)
  constexpr int NEAR=(MODE==1)?7:5;
  for(;t+NEAR<NT;t+=2){
    STEP(pB0,pB1,pA0,pA1,t,true,true,true);     WAIT_BAR(2); RESC(); ROT();
    STEP(pA0,pA1,pB0,pB1,t+1,true,true,true);   WAIT_BAR(2); RESC(); ROT();
  }
  #undef CMASK
  #define CMASK(P0,P1,t) do{int jb_=(t)-(NT-4); if(jb_>=0)cmask(P0,P1,jb_,qrel,hi);}while(0)
  #undef BIAS
  #define BIAS(P0,P1,t) do{ if constexpr(NOBIAS_) {} else if constexpr(MODE==0){ biasf(P0,P1,kbt+(64*(t)+4*hi)); } else { biasd(P0,P1,kb3,qrel-64*((t)-(NT-4))-4*hi); } }while(0)
  #define ENDW(tt) do{ if((tt)+3<NT){WAIT_BAR(2);} else if((tt)+2<NT){WAIT_BAR(1);} else {WAIT_BAR(0);} }while(0)
  for(;t+1<NT;t+=2){
    STEP(pB0,pB1,pA0,pA1,t,(t+3<NT),(t+1<NT),(t+1<NT));       ENDW(t);   RESC(); ROT();
    STEP(pA0,pA1,pB0,pB1,t+1,(t+4<NT),(t+2<NT),(t+2<NT));     ENDW(t+1); RESC(); ROT();
  }
  STEP(pB0,pB1,pA0,pA1,NT-1,false,false,false); RESC();
  { float sacc=pB0[0]+pB0[1]; _Pragma("unroll") for(int r=2;r<16;++r)sacc+=pB0[r]; _Pragma("unroll") for(int r=0;r<16;++r)sacc+=pB1[r]; l_reg+=sacc;
    pw0=(u32x4){PKW(pB0,0),PKW(pB0,2),PKW(pB0,4),PKW(pB0,6)};pw1=(u32x4){PKW(pB0,8),PKW(pB0,10),PKW(pB0,12),PKW(pB0,14)};pw2=(u32x4){PKW(pB1,0),PKW(pB1,2),PKW(pB1,4),PKW(pB1,6)};pw3=(u32x4){PKW(pB1,8),PKW(pB1,10),PKW(pB1,12),PKW(pB1,14)};
    SBAR(); pv(o,vb0+sl_cur,PAF(0),PAF(1),PAF(2),PAF(3)); }
  #undef PKW
  #undef PAF
  #undef VFR
  #undef PIN
  #undef MX3
  #undef GAPA
  #undef GAPB
  #undef EX
  #undef VRD
  #undef KRD
  #undef STEP
  #undef ENDW
  {auto rr=__builtin_amdgcn_permlane32_swap(__float_as_uint(l_reg),__float_as_uint(l_reg),false,false);l_reg=__uint_as_float(rr[0])+__uint_as_float(rr[1]);}
  if(hi==0)wsf[32+r32]=l_reg;asm volatile("s_waitcnt lgkmcnt(0)":::"memory");
  float rli[16];
  #pragma unroll
  for(int r=0;r<16;++r)rli[r]=__builtin_amdgcn_rcpf(wsf[32+crow(r,hi)]);
  bf16*Ow=O+(long)(q0+wid*QBLK)*OPITCH;
  { bf16*stg=(bf16*)(shm+LDS_OST)+wid*2048;
    #pragma unroll
    for(int r=0;r<16;++r){const int orow=crow(r,hi);
      #pragma unroll
      for(int d0=0;d0<2;++d0)stg[orow*64+d0*32+r32]=__float2bfloat16(o[d0][r]*rli[r]);}
    asm volatile("s_waitcnt lgkmcnt(0)":::"memory");
    #pragma unroll
    for(int i=0;i<4;++i){const int row=i*8+(lane>>3),ch=lane&7; const u32x4 v=*(const u32x4*)(stg+row*64+ch*8); ATTN_STORE16(Ow+(long)row*OPITCH+ch*8,v);} }
  asm volatile("s_waitcnt lgkmcnt(0)\n\ts_barrier":::"memory");
  #undef DMA_K
  #undef DMA_V
  #undef CMASK
  #undef BIAS
  #undef START
  #undef RESC
  #undef ROT
}
template<int THRL> __device__ __forceinline__ void attn_unit_d(int qb,const bf16*Q,const bf16*__restrict__ K,const bf16*__restrict__ V,bf16*O,const float*__restrict__ cum,const float*__restrict__ relb,const float thr,char*shm,const int wv){
  const int tid=::mk_tid(wv); const int lane=tid&63,r32=lane&31,hi=lane>>5; const int wid=wv;
  constexpr int MODE=1; constexpr int VSLOT=16384; constexpr int LDS_WS=LDS_V+NSLOT*VSLOT, LDS_OST=LDS_WS+NW*64*4, LDS_KB=LDS_OST+NW*4096; static_assert(LDS_KB+512<=LDS_BYTES,"lds");
  const int q0=qb*QB;
  const bf16*Qw=Q+(long)(q0+wid*QBLK)*PITCH;
  typedef __attribute__((address_space(3))) float* lds_fptr;
  const lds_fptr kb3=(lds_fptr)(__attribute__((address_space(3))) char*)shm+LDS_KB/4;
  if constexpr(MODE==0){ const float cref=cum[q0]; for(int i=tid;i<q0+QB;i+=NW*64)kb3[i]=(cref-cum[i])*1.4426950408889634f; }
  int tskip=0;
  if constexpr(MODE==0){
    asm volatile("s_waitcnt lgkmcnt(0)\n\ts_barrier":::"memory");
    const int ntf=(q0+QB)/KVBLK; const int c=(tid<ntf)?(kb3[64*tid+63]<=-thr?1:0):0;
    const int cnt=__popcll(__ballot(c));
    const __attribute__((address_space(3))) int* cw=(const __attribute__((address_space(3))) int*)((__attribute__((address_space(3))) char*)shm+LDS_CNT);
    if(lane==0)((__attribute__((address_space(3))) int*)cw)[wid]=cnt;
    asm volatile("s_waitcnt lgkmcnt(0)\n\ts_barrier":::"memory");
    tskip=(cw[0]+cw[1]+cw[2]+cw[3])&~1; tskip=__builtin_amdgcn_readfirstlane(tskip);
  }
  else { if(tid<128){ int bk=tid; if(tid>=16){ bk=16+(int)(__logf((float)tid*(1.f/16.f))/2.0794415416798357f*16.f); bk=bk>31?31:bk; } kb3[tid]=(relb[bk*4]-relb[31*4])*1.4426950408889634f; } }
  const unsigned lds0=(unsigned)(uintptr_t)shm;
  float*wsf=(float*)(shm+LDS_WS)+wid*64;
  const bf16*Kh=K+(long)tskip*KVBLK*PITCH,*Vh=V+(long)tskip*KVBLK*PITCH; const lds_fptr kbt=kb3+64*tskip;
  const rsrc4 rK=mk_rsrc(Kh), rV=mk_rsrc(Vh); const unsigned kvo=(unsigned)(lane*PITCH+wid*8)*2u;
  constexpr int VPITCH=128;
  const unsigned vvo=(unsigned)((16*(wid&3)+(lane>>2))*VPITCH+(wid>>2)*32+(lane&3)*8)*2u;
  const unsigned kdst=lds0+LDS_K+wid*1024, vdst=lds0+LDS_V+wid*1024;
  #define DMA_K(t,slot) bglds16(rK,kvo,(unsigned)__builtin_amdgcn_readfirstlane((t)*(KVBLK*PITCH*2)),(unsigned)__builtin_amdgcn_readfirstlane(kdst+(slot)))
  #define DMA_V(t,slot) do{ bglds16(rV,vvo,(unsigned)__builtin_amdgcn_readfirstlane((t)*(KVBLK*VPITCH*2)),(unsigned)__builtin_amdgcn_readfirstlane(vdst+(slot))); bglds16(rV,vvo,(unsigned)__builtin_amdgcn_readfirstlane((t)*(KVBLK*VPITCH*2)+128),(unsigned)__builtin_amdgcn_readfirstlane(vdst+8192+(slot))); }while(0)
  const int vb0=(int)(lds0+LDS_V)+((lane>>4)&1)*32+(lane&3)*8+(4*hi+((lane&15)>>2))*64;
  const char*Kbase=shm+LDS_K; bf16x8 kf[8];
  const lds_cptr shm3=(lds_cptr)shm; const lds_cptr kp0=shm3+LDS_K+hi*1024+r32*16; const lds_cptr vp0=shm3+LDS_V+((lane>>4)&1)*32+(lane&3)*8+(4*hi+((lane&15)>>2))*64;
  const int NT=(q0+QB)/KVBLK-tskip;
  DMA_K(0,0);DMA_V(0,0);DMA_K(1,SLOTB);
  bf16x8 qr[4];
  #pragma unroll
  for(int d0=0;d0<4;++d0)qr[d0]=*reinterpret_cast<const bf16x8*>(&Qw[(long)r32*PITCH+d0*16+hi*8]);
  float mhat=0.f,l_reg=0.f;f32x16 o[4];o[0]=f32x16{};o[1]=f32x16{};o[2]=f32x16{};o[3]=f32x16{};const f32x16 z16=f32x16{};
  const int qrel=wid*QBLK+r32;
  #define CMASK(P0,P1,t) do{int jb_=(t)-(NT-4); if(jb_>=0)cmask(P0,P1,jb_,qrel,hi);}while(0)
  #define BIAS(P0,P1,t) do{ if constexpr(NOBIAS_) {} else if constexpr(MODE==0){ biasf(P0,P1,kbt+(64*(t)+4*hi)); } else { biasd(P0,P1,kb3,qrel-64*((t)-(NT-4))-4*hi); } }while(0)
  bool resc=false;
  #define START(P0,P1) do{ const float rm=rowmax(P0,P1); resc=false; \
    { const float dl=rm; mhat=fadd_s(mhat,dl); \
      _Pragma("unroll") for(int r=0;r<16;++r){P0[r]=fsub_s(P0[r],dl);P1[r]=fsub_s(P1[r],dl);} \
      } \
    _Pragma("unroll") for(int r=0;r<16;++r)P0[r]=__builtin_amdgcn_exp2f(P0[r]); }while(0)
  #define RESC() do{ if(resc){ asm volatile("s_waitcnt lgkmcnt(0)":::"memory"); \
      _Pragma("unroll") for(int d_=0;d_<4;++d_) _Pragma("unroll") for(int r=0;r<16;++r)o[d_][r]*=wsf[crow(r,hi)]; } }while(0)
  f32x16 pA0,pA1,pB0,pB1;
  int sl_prev=0,sl_cur=0,sl_next=SLOTB;
  #define ROT() do{sl_prev=sl_cur;sl_cur=sl_next;sl_next=(sl_next==(NSLOT-1)*SLOTB)?0:sl_next+SLOTB;}while(0)
  DMA_K(2,2*SLOTB);
  WAIT_BAR(4);
  qkt(pA0,pA1,Kbase,qr,z16,r32,hi);asm volatile("s_nop 15\n\ts_nop 7":"+v"(pA0),"+v"(pA1));BIAS(pA0,pA1,0);CMASK(pA0,pA1,0);
  START(pA0,pA1);
  _Pragma("unroll") for(int r=0;r<16;++r)pA1[r]=__builtin_amdgcn_exp2f(pA1[r]);
  WAIT_BAR(0);
  DMA_K(3,0);DMA_V(1,VSLOT);
  ROT();
  kload8(kf,kp0+sl_cur);
  WAIT_BAR(3);
  s16x4 vlo[8],vhi[8]; u32x4 pw0,pw1,pw2,pw3;
  #define PKW(P,B) cvtpk_s(P[B],P[B+1])
  #define PAF(k) __builtin_bit_cast(bf16x8,pw##k)
  #define VFR(i) (bf16x8){vlo[i][0],vlo[i][1],vlo[i][2],vlo[i][3],vhi[i][0],vhi[i][1],vhi[i][2],vhi[i][3]}
  #define PIN(x) asm volatile("":"+v"(x))
  #define MX3(a,b,c) __builtin_fmaxf(__builtin_fmaxf((a),(b)),(c))
  #define GAPA(MF,A0,A1,A2,A3,W0,W1,PW) do{ MF; sacc+=A0; sacc+=A1; sacc+=A2; sacc+=A3; PIN(sacc); W0; W1; PIN(PW); SBAR(); }while(0)
  #define EX(v) __builtin_amdgcn_exp2f(v)
  #define GAPB(MF,X,B) do{ MF; X[B]=EX(X[B]); X[B+1]=EX(X[B+1]); PIN(X); SBAR(); }while(0)
  #define VRD2(i) do{ vlo[i]=vtr(vp_+(8192+((i)>>2)*4096+((i)&3)*1024)); vhi[i]=vtr(vp_+(8192+((i)>>2)*4096+((i)&3)*1024+512)); }while(0)
  #define VRD(i) do{ vlo[i]=vtr(vp_+(((i)>>2)*4096+((i)&3)*1024)); vhi[i]=vtr(vp_+(((i)>>2)*4096+((i)&3)*1024+512)); }while(0)
  #define KRD(G,j) do{ if(G){ kload2(kf,kp0+sl_next,j); SBAR(); } }while(0)
  #define STEP(C0,C1,P0,P1,t,GK,GV,GL) do{ SBAR(); \
    const lds_cptr vp_=vp0+2*sl_prev; \
    VRD(0); SBAR(); float sacc=(P0[0]+P0[1]); \
    GAPA(C0=__builtin_amdgcn_mfma_f32_32x32x16_bf16(kf[0],qr[0],z16,0,0,0), P0[2],P0[3],P0[4],P0[5],     pw0[0]=PKW(P0,0), pw0[1]=PKW(P0,2), pw0); \
    VRD(4); SBAR(); GAPA(C1=__builtin_amdgcn_mfma_f32_32x32x16_bf16(kf[1],qr[0],z16,0,0,0), P0[6],P0[7],P0[8],P0[9],     pw0[2]=PKW(P0,4), pw0[3]=PKW(P0,6), pw0); \
    VRD(1); SBAR(); GAPA(C0=__builtin_amdgcn_mfma_f32_32x32x16_bf16(kf[2],qr[1],C0,0,0,0),   P0[10],P0[11],P0[12],P0[13], pw1[0]=PKW(P0,8), pw1[1]=PKW(P0,10), pw1); \
    VRD(5); SBAR(); GAPA(C1=__builtin_amdgcn_mfma_f32_32x32x16_bf16(kf[3],qr[1],C1,0,0,0),   P0[14],P0[15],P1[0],P1[1],   pw1[2]=PKW(P0,12),pw1[3]=PKW(P0,14), pw1); \
    VRD(2); SBAR(); GAPA(C0=__builtin_amdgcn_mfma_f32_32x32x16_bf16(kf[4],qr[2],C0,0,0,0),   P1[2],P1[3],P1[4],P1[5],     pw2[0]=PKW(P1,0), pw2[1]=PKW(P1,2), pw2); \
    VRD(6); SBAR(); GAPA(C1=__builtin_amdgcn_mfma_f32_32x32x16_bf16(kf[5],qr[2],C1,0,0,0),   P1[6],P1[7],P1[8],P1[9],     pw2[2]=PKW(P1,4), pw2[3]=PKW(P1,6), pw2); \
    VRD(3); SBAR(); GAPA(C0=__builtin_amdgcn_mfma_f32_32x32x16_bf16(kf[6],qr[3],C0,0,0,0),   P1[10],P1[11],P1[12],P1[13], pw3[0]=PKW(P1,8), pw3[1]=PKW(P1,10), pw3); \
    VRD(7); SBAR(); GAPA(C1=__builtin_amdgcn_mfma_f32_32x32x16_bf16(kf[7],qr[3],C1,0,0,0),   P1[14],P1[15],0.f,0.f,       pw3[2]=PKW(P1,12),pw3[3]=PKW(P1,14), pw3); \
    l_reg+=sacc; \
    if(GK){DMA_K((t)+3,sl_cur);} if(GV){DMA_V((t)+1,2*sl_next);} \
    BIAS(C0,C1,t); CMASK(C0,C1,t); submh(C0,C1,mhat); \
    { float a=MX3(C0[0],C0[1],C1[0]),b=MX3(C0[2],C0[3],C1[1]); a=MX3(a,C1[2],C1[3]); \
      _Pragma("unroll") for(int r=4;r<16;r+=4){a=MX3(a,C0[r],C0[r+1]);b=MX3(b,C0[r+2],C0[r+3]);a=MX3(a,C1[r],C1[r+1]);b=MX3(b,C1[r+2],C1[r+3]);} \
      float rm=__builtin_fmaxf(a,b); { auto rr=__builtin_amdgcn_permlane32_swap(__float_as_uint(rm),__float_as_uint(rm),false,false); rm=__builtin_fmaxf(__uint_as_float(rr[0]),__uint_as_float(rr[1])); } \
      resc=false; \
      if(__builtin_expect(__any(rm>(float)THRL),0)){ const float dl=__builtin_fmaxf(rm,0.f); mhat+=dl; \
        _Pragma("unroll") for(int r=0;r<16;++r){C0[r]-=dl;C1[r]-=dl;} \
        const float f=__builtin_amdgcn_exp2f(-dl); l_reg*=f; if(hi==0)wsf[r32]=f; resc=true; } } \
    SBAR(); \
    GAPB(o[0]=__builtin_amdgcn_mfma_f32_32x32x16_bf16(PAF(0),VFR(0),o[0],0,0,0), C0,0);  VRD2(0); SBAR(); \
    GAPB(o[1]=__builtin_amdgcn_mfma_f32_32x32x16_bf16(PAF(0),VFR(4),o[1],0,0,0), C0,2);  VRD2(4); SBAR(); \
    KRD(GL,0); GAPB(o[0]=__builtin_amdgcn_mfma_f32_32x32x16_bf16(PAF(1),VFR(1),o[0],0,0,0), C0,4);  VRD2(1); SBAR(); \
    KRD(GL,1); GAPB(o[1]=__builtin_amdgcn_mfma_f32_32x32x16_bf16(PAF(1),VFR(5),o[1],0,0,0), C0,6);  VRD2(5); SBAR(); \
    KRD(GL,2); GAPB(o[0]=__builtin_amdgcn_mfma_f32_32x32x16_bf16(PAF(2),VFR(2),o[0],0,0,0), C0,8);  VRD2(2); SBAR(); \
    KRD(GL,3); GAPB(o[1]=__builtin_amdgcn_mfma_f32_32x32x16_bf16(PAF(2),VFR(6),o[1],0,0,0), C0,10); VRD2(6); SBAR(); \
    GAPB(o[0]=__builtin_amdgcn_mfma_f32_32x32x16_bf16(PAF(3),VFR(3),o[0],0,0,0), C0,12); VRD2(3); SBAR(); \
    GAPB(o[1]=__builtin_amdgcn_mfma_f32_32x32x16_bf16(PAF(3),VFR(7),o[1],0,0,0), C0,14); VRD2(7); SBAR(); \
    GAPB(o[2]=__builtin_amdgcn_mfma_f32_32x32x16_bf16(PAF(0),VFR(0),o[2],0,0,0), C1,0); \
    GAPB(o[3]=__builtin_amdgcn_mfma_f32_32x32x16_bf16(PAF(0),VFR(4),o[3],0,0,0), C1,2); \
    GAPB(o[2]=__builtin_amdgcn_mfma_f32_32x32x16_bf16(PAF(1),VFR(1),o[2],0,0,0), C1,4); \
    GAPB(o[3]=__builtin_amdgcn_mfma_f32_32x32x16_bf16(PAF(1),VFR(5),o[3],0,0,0), C1,6); \
    GAPB(o[2]=__builtin_amdgcn_mfma_f32_32x32x16_bf16(PAF(2),VFR(2),o[2],0,0,0), C1,8); \
    GAPB(o[3]=__builtin_amdgcn_mfma_f32_32x32x16_bf16(PAF(2),VFR(6),o[3],0,0,0), C1,10); \
    GAPB(o[2]=__builtin_amdgcn_mfma_f32_32x32x16_bf16(PAF(3),VFR(3),o[2],0,0,0), C1,12); \
    GAPB(o[3]=__builtin_amdgcn_mfma_f32_32x32x16_bf16(PAF(3),VFR(7),o[3],0,0,0), C1,14); \
    }while(0)
  int t=1;
  #undef CMASK
  #define CMASK(P0,P1,t) do{}while(0)
  #undef BIAS
  #define BIAS(P0,P1,t) do{ if constexpr(NOBIAS_) {} else if constexpr(MODE==0){ biasf(P0,P1,kbt+(64*(t)+4*hi)); } }while(0)
  constexpr int NEAR=(MODE==1)?7:5;
  for(;t+NEAR<NT;t+=2){
    STEP(pB0,pB1,pA0,pA1,t,true,true,true);     WAIT_BAR(3); RESC(); ROT();
    STEP(pA0,pA1,pB0,pB1,t+1,true,true,true);   WAIT_BAR(3); RESC(); ROT();
  }
  #undef CMASK
  #define CMASK(P0,P1,t) do{int jb_=(t)-(NT-4); if(jb_>=0)cmask(P0,P1,jb_,qrel,hi);}while(0)
  #undef BIAS
  #define BIAS(P0,P1,t) do{ if constexpr(NOBIAS_) {} else if constexpr(MODE==0){ biasf(P0,P1,kbt+(64*(t)+4*hi)); } else { biasd(P0,P1,kb3,qrel-64*((t)-(NT-4))-4*hi); } }while(0)
  #define ENDW(tt) do{ if((tt)+3<NT){WAIT_BAR(3);} else if((tt)+2<NT){WAIT_BAR(2);} else {WAIT_BAR(0);} }while(0)
  for(;t+1<NT;t+=2){
    STEP(pB0,pB1,pA0,pA1,t,(t+3<NT),(t+1<NT),(t+1<NT));       ENDW(t);   RESC(); ROT();
    STEP(pA0,pA1,pB0,pB1,t+1,(t+4<NT),(t+2<NT),(t+2<NT));     ENDW(t+1); RESC(); ROT();
  }
  STEP(pB0,pB1,pA0,pA1,NT-1,false,false,false); RESC();
  { float sacc=pB0[0]+pB0[1]; _Pragma("unroll") for(int r=2;r<16;++r)sacc+=pB0[r]; _Pragma("unroll") for(int r=0;r<16;++r)sacc+=pB1[r]; l_reg+=sacc;
    pw0=(u32x4){PKW(pB0,0),PKW(pB0,2),PKW(pB0,4),PKW(pB0,6)};pw1=(u32x4){PKW(pB0,8),PKW(pB0,10),PKW(pB0,12),PKW(pB0,14)};pw2=(u32x4){PKW(pB1,0),PKW(pB1,2),PKW(pB1,4),PKW(pB1,6)};pw3=(u32x4){PKW(pB1,8),PKW(pB1,10),PKW(pB1,12),PKW(pB1,14)};
    SBAR(); pv(o,vb0+2*sl_cur,PAF(0),PAF(1),PAF(2),PAF(3)); pv(o+2,vb0+2*sl_cur+8192,PAF(0),PAF(1),PAF(2),PAF(3)); }
  #undef PKW
  #undef PAF
  #undef VFR
  #undef PIN
  #undef MX3
  #undef GAPA
  #undef GAPB
  #undef EX
  #undef VRD
  #undef VRD2
  #undef KRD
  #undef STEP
  #undef ENDW
  {auto rr=__builtin_amdgcn_permlane32_swap(__float_as_uint(l_reg),__float_as_uint(l_reg),false,false);l_reg=__uint_as_float(rr[0])+__uint_as_float(rr[1]);}
  if(hi==0)wsf[32+r32]=l_reg;asm volatile("s_waitcnt lgkmcnt(0)":::"memory");
  float rli[16];
  #pragma unroll
  for(int r=0;r<16;++r)rli[r]=__builtin_amdgcn_rcpf(wsf[32+crow(r,hi)]);
  bf16*Ow=O+(long)(q0+wid*QBLK)*OPITCH;
  { bf16*stg=(bf16*)(shm+LDS_OST)+wid*2048;
    #pragma unroll
    for(int ps=0;ps<2;++ps){
      #pragma unroll
      for(int r=0;r<16;++r){const int orow=crow(r,hi);
        #pragma unroll
        for(int d0=0;d0<2;++d0)stg[orow*64+d0*32+r32]=__float2bfloat16(o[2*ps+d0][r]*rli[r]);}
      asm volatile("s_waitcnt lgkmcnt(0)":::"memory");
      #pragma unroll
      for(int i=0;i<4;++i){const int row=i*8+(lane>>3),ch=lane&7; const u32x4 v=*(const u32x4*)(stg+row*64+ch*8); ATTN_STORE16(Ow+(long)row*OPITCH+ps*64+ch*8,v);}
      asm volatile("s_waitcnt lgkmcnt(0)":::"memory"); } }
  asm volatile("s_waitcnt lgkmcnt(0)\n\ts_barrier":::"memory");
  #undef DMA_K
  #undef DMA_V
  #undef CMASK
  #undef BIAS
  #undef START
  #undef RESC
  #undef ROT
}
constexpr int ATTN_LDS_BYTES=LDS_BYTES;
#undef SBAR
#undef WAIT_BAR
}
#define LAS __attribute__((address_space(3)))
typedef unsigned short bf16;
typedef unsigned v4u __attribute__((ext_vector_type(4)));
typedef unsigned v2u __attribute__((ext_vector_type(2)));
typedef float f32x4 __attribute__((ext_vector_type(4)));
constexpr int NWAVES = 8, NT = 512;
constexpr int M = 16384, DMODEL = 1024, NIN = 5128, NPROJ = 5120, DFF = 2816, DFFE = 3584, NEXP = 8;
constexpr float LN_EPS = 1e-5f, SUBLN_EPS = 1e-5f, ALPHA = 1.4142135623730951f  , LOG2E = 1.4426950408889634f;
constexpr size_t MiB = 1u << 20;
constexpr size_t WS_CTL = 0;
constexpr size_t WS_BAR = 16384;
constexpr size_t WS_LOGF = 1 * MiB, WS_CUM = 2 * MiB, WS_EIDX = 3 * MiB, WS_GW = 3 * MiB + 256 * 1024, WS_POS = 3 * MiB + 512 * 1024, WS_TILEE = 3 * MiB + 768 * 1024;
constexpr size_t WS_STATS = 4 * MiB;
constexpr size_t WS_WIN = 16 * MiB, WS_WBR = 36 * MiB, WS_WO = 40 * MiB, WS_WGU = 44 * MiB, WS_WDN = 55 * MiB, WS_WEGU = 61 * MiB, WS_WEDN = 173 * MiB;
constexpr size_t WS_H = 229 * MiB, WS_HB = 293 * MiB;
constexpr size_t WS_PROJ = 325 * MiB, WS_YATT = 485 * MiB, WS_ODIFF = 517 * MiB, WS_T = 549 * MiB, WS_MERGED = 613 * MiB, WS_Z = 645 * MiB, WS_ACT = 709 * MiB;
constexpr size_t WS_XS = 325 * MiB, WS_ACTS = 393 * MiB, WS_YS = 709 * MiB, WS_END = 845 * MiB;
#ifndef DENSE_FP8_MODE
#define DENSE_FP8_MODE 2
#endif
constexpr int DENSE_FP8 = DENSE_FP8_MODE;
constexpr float W8_SCALE = 64.f, A8_SCALE = 16.f;
constexpr int MAXP = 2 * M + NEXP * 256;
static_assert(WS_XS + (size_t)MAXP * 1024 * 2 <= WS_ACTS && WS_ACTS + (size_t)MAXP * DFFE * 2 <= WS_Z && WS_YS + (size_t)MAXP * 1024 * 4 <= WS_END, "moe overlay");
static_assert(WS_PROJ + (size_t)M * NPROJ * 2 <= WS_YATT && WS_ACT + (size_t)M * DFF * 2 <= WS_END, "ws map");
constexpr int LDS_BYTES = attn_body::LDS_BYTES + 1024;
static_assert(attn_body::LDS_BYTES >= pg8::STAGE_BYTES && LDS_BYTES <= 163840, "lds");

__device__ __forceinline__ unsigned f2bf(float f) { unsigned u = __builtin_bit_cast(unsigned, f); return (u + 0x7fffu + ((u >> 16) & 1u)) >> 16; }
__device__ __forceinline__ unsigned pk2(float lo, float hi) { return f2bf(lo) | (f2bf(hi) << 16); }
__device__ __forceinline__ float wave_sum(float v) {
#pragma unroll
    for (int o = 1; o < 64; o <<= 1) v += shx(v, o);
    return v;
}
__device__ __forceinline__ void tr_block(const float* src  , int ldw, bf16* dst  , int K, LAS float* scr, int lane) {
    const int kr = lane >> 3, c4 = lane & 7;
    f32x4 v[8];
#pragma unroll
    for (int i = 0; i < 8; ++i) v[i] = *(const f32x4*)(src + (size_t)(8 * i + kr) * ldw + 4 * c4);
#pragma unroll
    for (int i = 0; i < 8; ++i) { LAS float* d = scr + (8 * i + kr) * 33 + 4 * c4; d[0] = v[i].x; d[1] = v[i].y; d[2] = v[i].z; d[3] = v[i].w; }
    asm volatile("s_waitcnt lgkmcnt(0)" ::: "memory");
    const int c = lane & 7;
#pragma unroll
    for (int j = 0; j < 4; ++j) { const int n = (lane >> 3) + 8 * j; const LAS float* s = scr + (8 * c) * 33 + n;
        v4u o; o.x = pk2(s[0 * 33], s[1 * 33]); o.y = pk2(s[2 * 33], s[3 * 33]); o.z = pk2(s[4 * 33], s[5 * 33]); o.w = pk2(s[6 * 33], s[7 * 33]);
        *(v4u*)(dst + (size_t)n * K + 8 * c) = o; }
    asm volatile("s_waitcnt lgkmcnt(0)" ::: "memory");
}
__device__ __forceinline__ void tr_block8(const float* src, int ldw, unsigned char* dst  , int Kb, float sc, LAS float* scr, int lane) {
    const int kr = lane >> 3, c4 = lane & 7;
    f32x4 v[8];
#pragma unroll
    for (int i = 0; i < 8; ++i) v[i] = *(const f32x4*)(src + (size_t)(8 * i + kr) * ldw + 4 * c4);
#pragma unroll
    for (int i = 0; i < 8; ++i) { LAS float* d = scr + (8 * i + kr) * 33 + 4 * c4; d[0] = v[i].x; d[1] = v[i].y; d[2] = v[i].z; d[3] = v[i].w; }
    asm volatile("s_waitcnt lgkmcnt(0)" ::: "memory");
    const int c = lane & 7;
#pragma unroll
    for (int j = 0; j < 4; ++j) { const int n = (lane >> 3) + 8 * j; const LAS float* s = scr + (8 * c) * 33 + n;
        int w0 = 0, w1 = 0; w0 = __builtin_amdgcn_cvt_pk_fp8_f32(s[0 * 33] * sc, s[1 * 33] * sc, w0, false); w0 = __builtin_amdgcn_cvt_pk_fp8_f32(s[2 * 33] * sc, s[3 * 33] * sc, w0, true);
        w1 = __builtin_amdgcn_cvt_pk_fp8_f32(s[4 * 33] * sc, s[5 * 33] * sc, w1, false); w1 = __builtin_amdgcn_cvt_pk_fp8_f32(s[6 * 33] * sc, s[7 * 33] * sc, w1, true);
        *(v2u*)(dst + (size_t)n * Kb + 8 * c) = (v2u){(unsigned)w0, (unsigned)w1}; }
    asm volatile("s_waitcnt lgkmcnt(0)" ::: "memory");
}
template <int MAP> __device__ __forceinline__ void tr_seg8(const float* W, int ldw, int K, int c0, int ncols, unsigned char* WT, int row_off, int F, float sc, LAS float* scr, int item, int lane) {
    const int nblk = ncols / 32, kb = item / nblk, nb = item % nblk, k0 = 64 * kb, n0 = 32 * nb;
    int drow;
    if (MAP == 0) drow = row_off + n0; else { int c = n0; const int up = c >= F; if (up) c -= F; drow = row_off + 256 * (c / 128) + 128 * up + (c % 128); }
    tr_block8(W + (size_t)k0 * ldw + c0 + n0, ldw, WT + (size_t)drow * K + k0, K, sc, scr, lane);
}
template <int MAP> __device__ __forceinline__ void tr_seg(const float* W, int ldw, int K, int c0, int ncols, bf16* WT, int row_off, int F, LAS float* scr, int item, int lane) {
    const int nblk = ncols / 32, kb = item / nblk, nb = item % nblk, k0 = 64 * kb, n0 = 32 * nb;
    int drow;
    if (MAP == 0) drow = row_off + n0; else { int c = n0; const int up = c >= F; if (up) c -= F; drow = row_off + 256 * (c / 128) + 128 * up + (c % 128); }
    tr_block(W + (size_t)k0 * ldw + c0 + n0, ldw, WT + (size_t)drow * K + k0, K, scr, lane);
}

#define XB_TMO      128
#define XB_XCNT(j)  (256  + 64 * (j))
#define XB_XSUB(j)  (1280 + 64 * (j))
#define XB_XGEN(j)  (2304 + 64 * (j))
#define XB_TOP      3328
#define XB_TOPGEN   3392
#define XCD_BAR_WORDS 3456
#define XB_SPIN_CAP (1u << 18)

__device__ __forceinline__ unsigned xb_ld(unsigned* p)              { return __hip_atomic_load(p, __ATOMIC_RELAXED, __HIP_MEMORY_SCOPE_AGENT); }
__device__ __forceinline__ unsigned xb_add(unsigned* p, unsigned v) { return __hip_atomic_fetch_add(p, v, __ATOMIC_RELAXED, __HIP_MEMORY_SCOPE_AGENT); }
__device__ __forceinline__ unsigned xb_xcc_id() { return (unsigned)__builtin_amdgcn_s_getreg((3 << 11) | 20) & 0xFu; }
#define XB_SPIN(cond, bar) do { unsigned _sp = 0; while (cond) { __builtin_amdgcn_s_sleep(1); \
    if ((++_sp & 255u) == 0u) { if (xb_ld(&(bar)[XB_TMO])) break; if (_sp > XB_SPIN_CAP) { atomicAdd(&(bar)[XB_TMO], 1u); break; } } } } while (0)

struct XcdBarrier {
    unsigned* bar; unsigned x;
    volatile LAS unsigned* st;
};

__device__ __forceinline__ XcdBarrier xcd_barrier_post(unsigned* bar, volatile LAS unsigned* st, const int wv) {
    XcdBarrier b; b.bar = bar; b.x = xb_xcc_id(); b.st = st;
    if (mk_tid(wv) == 0) (void)xb_add(&bar[XB_XCNT(b.x)], 1u);
    return b;
}
__device__ __forceinline__ void xcd_barrier_complete(unsigned* bar, unsigned x, unsigned& nloc, unsigned& nx) {
    const unsigned G = gridDim.x * gridDim.y * gridDim.z;
    unsigned sum, cnt, mine, sp = 0u;
    for (;;) {
        sum = 0u; cnt = 0u; mine = 0u;
#pragma unroll
        for (unsigned j = 0; j < 16; ++j) { const unsigned c = xb_ld(&bar[XB_XCNT(j)]); sum += c; cnt += (c > 0u) ? 1u : 0u; mine = (j == x) ? c : mine; }
        if (sum == G) break;
        __builtin_amdgcn_s_sleep(1);
        if ((++sp & 255u) == 0u) { if (xb_ld(&bar[XB_TMO])) break; if (sp > XB_SPIN_CAP) { atomicAdd(&bar[XB_TMO], 1u); break; } }
    }
    nloc = mine > 0u ? mine : 1u; nx = cnt > 0u ? cnt : 1u;
}

__device__ __forceinline__ void xcd_barrier(const XcdBarrier& b, const int wv) {
    asm volatile("s_waitcnt vmcnt(0)" ::: "memory");
    __syncthreads();
    if (mk_tid(wv) == 0) {
        unsigned* bar = b.bar;
        __builtin_amdgcn_s_waitcnt(0);
        unsigned nloc = b.st[0], nx = b.st[1];
        if (nloc == 0u) { xcd_barrier_complete(bar, b.x, nloc, nx); b.st[0] = nloc; b.st[1] = nx; }
        const unsigned old = xb_add(&bar[XB_XSUB(b.x)], 1u);
        const unsigned gen = old / nloc;
        if (old + 1u == (gen + 1u) * nloc) {
            __builtin_amdgcn_fence(__ATOMIC_RELEASE, "agent");
            asm volatile("s_waitcnt vmcnt(0)" ::: "memory");
            const unsigned og = xb_add(&bar[XB_TOP], 1u);
            const unsigned tg = og / nx;
            if (og + 1u == (tg + 1u) * nx) xb_add(&bar[XB_TOPGEN], 1u);
            else XB_SPIN(xb_ld(&bar[XB_TOPGEN]) == tg, bar);
            __builtin_amdgcn_fence(__ATOMIC_ACQUIRE, "agent");
            xb_add(&bar[XB_XGEN(b.x)], 1u);
            asm volatile("s_waitcnt vmcnt(0)" ::: "memory");
        } else {
            XB_SPIN(xb_ld(&bar[XB_XGEN(b.x)]) == gen, bar);
            __builtin_amdgcn_fence(__ATOMIC_ACQUIRE, "agent");
            asm volatile("s_waitcnt vmcnt(0)" ::: "memory");
        }
    }
    __syncthreads();
}

__device__ __forceinline__ unsigned char* launder(unsigned char* p) { asm volatile("" : "+s"(p)); return p; }
typedef const __attribute__((address_space(4))) unsigned char* karg_ptr;
__device__ __forceinline__ karg_ptr karg_base() { karg_ptr p = (karg_ptr)__builtin_amdgcn_kernarg_segment_ptr(); asm volatile("" : "+s"(p)); return p; }
struct KArgIn { __device__ __forceinline__ const float* operator[](int k) const { return *(const float* const __attribute__((address_space(4)))*)(karg_base() + 8 * k); } };
__device__ __forceinline__ float* karg_out() { return *(float* const __attribute__((address_space(4)))*)(karg_base() + 184); }
__device__ __forceinline__ unsigned char* karg_ws() { return *(unsigned char* const __attribute__((address_space(4)))*)(karg_base() + 192); }
struct Args { const float* in[23]; float* out; unsigned char* ws; };

template <int SRC, int EXTRA, bool OUT8 = false>
__device__ __forceinline__ void ln_phase(LAS unsigned char* lds, int G, const float* src, const pg8::PrevLN hp, const float* ys, const int* pos, const float* gwt, const int* tailid, const float* part,
                                         const float* g, const float* b, float* of32, float* stats, bf16* obf, const float* w8, int w8ld, const float* bf8, float* logf, int* eidx, float* gwout, unsigned* gcount, const int wv) {
    const int tid = mk_tid(wv); const int lane = tid & 63, wave = wv;
    LAS float* w8s = (LAS float*)lds;
    LAS unsigned* lcnt = (LAS unsigned*)(lds + 32768);
    if (EXTRA != 0) { for (int i = tid; i < 8192; i += NT) { const int k = i >> 3, j = i & 7; w8s[j * 1024 + k] = w8[(size_t)k * w8ld + j]; } if (tid < 8) lcnt[tid] = 0u; __syncthreads(); }
    f32x4 gv[4], bv[4];
#pragma unroll
    for (int j = 0; j < 4; ++j) { gv[j] = *(const f32x4*)(g + 256 * j + 4 * lane); bv[j] = *(const f32x4*)(b + 256 * j + 4 * lane); }
    const int gw = blockIdx.x * NWAVES + wave, NGW = G * NWAVES;
    for (int row = gw; row < M; row += NGW) {
        f32x4 v[4];
        if (SRC == 0) {
#pragma unroll
            for (int j = 0; j < 4; ++j) v[j] = *(const f32x4*)(src + (size_t)row * 1024 + 256 * j + 4 * lane);
        } else {
            const int p0 = pos[2 * row], p1 = pos[2 * row + 1]; const float w0 = gwt[2 * row], w1 = gwt[2 * row + 1]; const float hm = hp.stats[2 * row], hr = hp.stats[2 * row + 1];
#pragma unroll
            for (int j = 0; j < 4; ++j) { const f32x4 a = (*(const f32x4*)(hp.src + (size_t)row * 1024 + 256 * j + 4 * lane) - hm) * hr * *(const f32x4*)(hp.g + 256 * j + 4 * lane) + *(const f32x4*)(hp.b + 256 * j + 4 * lane);
                f32x4 y[2];
#pragma unroll
                for (int q = 0; q < 2; ++q) { const int p = q ? p1 : p0; const int t = __builtin_amdgcn_readfirstlane(tailid[(p >> 8) * 4 + j]);
                    if (t < 0) y[q] = *(const f32x4*)(ys + (size_t)p * 1024 + 256 * j + 4 * lane);
                    else { f32x4 acc = (f32x4){0.f, 0.f, 0.f, 0.f};
#pragma unroll
                        for (int sl = 0; sl < 7; ++sl) acc = acc + *(const f32x4*)(part + ((size_t)(t * 7 + sl) * 256 + (p & 255)) * 256 + 4 * lane);
                        y[q] = acc; } }
                v[j] = a * ALPHA + y[0] * w0 + y[1] * w1; }
        }
        float s = 0.f;
#pragma unroll
        for (int j = 0; j < 4; ++j) s += (v[j].x + v[j].y) + (v[j].z + v[j].w);
        const float mean = wave_sum(s) * (1.f / 1024.f); float s2 = 0.f;
#pragma unroll
        for (int j = 0; j < 4; ++j) { v[j] = v[j] - mean; s2 += (v[j].x * v[j].x + v[j].y * v[j].y) + (v[j].z * v[j].z + v[j].w * v[j].w); }
        const float rstd = 1.f / sqrtf(wave_sum(s2) * (1.f / 1024.f) + LN_EPS);
        if (stats && lane == 0) { stats[2 * row] = mean; stats[2 * row + 1] = rstd; }
#pragma unroll
        for (int j = 0; j < 4; ++j) { v[j] = v[j] * rstd * gv[j] + bv[j]; if (of32) *(f32x4*)(of32 + (size_t)row * 1024 + 256 * j + 4 * lane) = v[j];
            if (obf) { if constexpr (OUT8) { int w = 0; w = __builtin_amdgcn_cvt_pk_fp8_f32(v[j].x, v[j].y, w, false); w = __builtin_amdgcn_cvt_pk_fp8_f32(v[j].z, v[j].w, w, true); *(unsigned*)((unsigned char*)obf + (size_t)row * 1024 + 256 * j + 4 * lane) = (unsigned)w; }
                else { v2u o; o.x = pk2(v[j].x, v[j].y); o.y = pk2(v[j].z, v[j].w); *(v2u*)(obf + (size_t)row * 1024 + 256 * j + 4 * lane) = o; } } }
        if (EXTRA != 0) {
            float d[8];
#pragma unroll
            for (int e = 0; e < 8; ++e) { float a = 0.f;
#pragma unroll
                for (int j = 0; j < 4; ++j) { const f32x4 w = *(const LAS f32x4*)(w8s + e * 1024 + 256 * j + 4 * lane); a += (v[j].x * w.x + v[j].y * w.y) + (v[j].z * w.z + v[j].w * w.w); }
                d[e] = wave_sum(a); }
            if (EXTRA == 1) {
                float x = d[0];
#pragma unroll
                for (int e = 1; e < 8; ++e) x = (lane == e) ? d[e] : x;
                if (lane < 8) { x += bf8[lane]; const float ls = (x >= 0.f) ? -log1pf(__expf(-x)) : (x - log1pf(__expf(x))); logf[(size_t)lane * M + row] = ls; }
            } else {
                int i0 = 0; float v0 = d[0];
#pragma unroll
                for (int e = 1; e < 8; ++e) if (d[e] > v0) { v0 = d[e]; i0 = e; }
                int i1 = -1; float v1 = -INFINITY;
#pragma unroll
                for (int e = 0; e < 8; ++e) if (e != i0 && d[e] > v1) { v1 = d[e]; i1 = e; }
                if (lane == 0) { const float w0 = 1.f / (1.f + __expf(v1 - v0)); eidx[row] = i0 | (i1 << 8); gwout[2 * row] = w0; gwout[2 * row + 1] = 1.f - w0;
                    atomicAdd((unsigned*)&lcnt[i0], 1u); atomicAdd((unsigned*)&lcnt[i1], 1u); }
            }
        }
    }
    if (EXTRA == 2) { __syncthreads(); if (tid < 8) atomicAdd(gcount + tid, lcnt[tid]); }
}

#define GSYNC_CG() do { if constexpr (SEL < 0) cg::this_grid().sync(); } while (0)
#define GSYNC() do { if constexpr (SEL < 0) { XcdBarrier b_; b_.bar = (unsigned*)(karg_ws() + WS_BAR); b_.x = xb_xcc_id(); b_.st = (volatile LAS unsigned*)(ldsp + attn_body::LDS_BYTES); xcd_barrier(b_, wv); } } while (0)
#define PHASE(id) if constexpr (SEL < 0 || SEL == (id))
#ifndef PHM
#define PHM 0xffffffffu
#endif
#ifndef REP_G
#define REP_G 1
#endif
#ifndef REP_A
#define REP_A 1
#endif
#ifndef REP_P
#define REP_P 1
#endif
#define GEMM_PHASE8(EpiT, SchedT, gg, SS, EE) pg8::gemm_phase<EpiT, SchedT, true, true, true>(ldsp, gg, SS, EE, wv)
#define GEMM_PHASE(EpiT, SchedT, gg, SS, EE) do { pg8::gemm_phase<EpiT, SchedT, true, true>(ldsp, gg, SS, EE, wv); if constexpr (REP_G > 1) { pg8::gemm_phase<EpiT, SchedT, true, true>(ldsp, gg, SS, EE, wv); } } while (0)

#define q_ctl ((unsigned*)(karg_ws() + WS_CTL))
#define q_logf ((float*)(karg_ws() + WS_LOGF))
#define q_cum ((float*)(karg_ws() + WS_CUM))
#define q_eidx ((int*)(karg_ws() + WS_EIDX))
#define q_gwt ((float*)(karg_ws() + WS_GW))
#define q_pos ((int*)(karg_ws() + WS_POS))
#define q_tile_e ((int*)(karg_ws() + WS_TILEE))
#define q_Win_t ((bf16*)(karg_ws() + WS_WIN))
#define q_Wbr_t ((bf16*)(karg_ws() + WS_WBR))
#define q_Wo_t ((bf16*)(karg_ws() + WS_WO))
#define q_Wgu_t ((bf16*)(karg_ws() + WS_WGU))
#define q_Wdn_t ((bf16*)(karg_ws() + WS_WDN))
#define q_Wegu_t ((bf16*)(karg_ws() + WS_WEGU))
#define q_Wedn_t ((bf16*)(karg_ws() + WS_WEDN))
#define q_h ((float*)(karg_ws() + WS_H))
#define q_stats ((float*)(karg_ws() + WS_STATS))
#define q_hb ((bf16*)(karg_ws() + WS_HB))
#define q_proj ((bf16*)(karg_ws() + WS_PROJ))
#define q_yatt ((bf16*)(karg_ws() + WS_YATT))
#define q_odiff ((bf16*)(karg_ws() + WS_ODIFF))
#define q_Tb ((float*)(karg_ws() + WS_T))
#define q_merged ((bf16*)(karg_ws() + WS_MERGED))
#define q_z ((float*)(karg_ws() + WS_Z))
#define q_act ((bf16*)(karg_ws() + WS_ACT))
#define q_Xs ((bf16*)(karg_ws() + WS_XS))
#define q_acts ((bf16*)(karg_ws() + WS_ACTS))
#define q_ys ((float*)(karg_ws() + WS_YS))
#define in KArgIn()

__device__ __forceinline__ int tid_fresh(int wv) { return mk_tid(wv); }
#define FRESH_IDS() const int tid = tid_fresh(wv), lane = tid & 63, wave = wv
template <int l, int SEL> __device__ __forceinline__ void layer_body(const Args& args, LAS unsigned char* ldsp, unsigned char* lds, const int G, const int bx, const int vcu, const int wv) {
        constexpr int B = 1 + 10 * l;
        PHASE(B + 0) {
        if (bx < 8) {
            FRESH_IDS();
            const float* lf = q_logf + (size_t)bx * M + 32 * tid; float* co = q_cum + (size_t)bx * M + 32 * tid;
            f32x4 v[8]; float run = 0.f;
#pragma unroll
            for (int j = 0; j < 8; ++j) { v[j] = *(const f32x4*)(lf + 4 * j); v[j].x += run; v[j].y += v[j].x; v[j].z += v[j].y; v[j].w += v[j].z; run = v[j].w; }
            float inc = run;
#pragma unroll
            for (int o = 1; o < 64; o <<= 1) { const float t = __shfl_up(inc, o); if (lane >= o) inc += t; }
            LAS float* wt = (LAS float*)ldsp;
            if (lane == 63) wt[wave] = inc;
            __syncthreads();
            float base = inc - run;
            for (int w = 0; w < wave; ++w) base += wt[w];
#pragma unroll
            for (int j = 0; j < 8; ++j) *(f32x4*)(co + 4 * j) = v[j] + base;
            __syncthreads();
        }
        {
            pg8::Gemm g{q_hb, q_Win_t + (size_t)l * NPROJ * 1024, M, NPROJ, 1024}; pg8::StaticOrder S; S.init(M, NPROJ, G, bx);
            pg8::EpiProj E{q_proj, attn_body::C2, q_ctl + 16};
            if (PHM & (1u << 1)) GEMM_PHASE(pg8::EpiProj, pg8::StaticOrder, g, S, E);
#ifdef REP_INPROJ
            GEMM_PHASE(pg8::EpiProj, pg8::StaticOrder, g, S, E);
#endif
        }
        }
        GSYNC();

        PHASE(B + 1) {
            typedef attn_body::bf16 abf;
            const abf* pj = (const abf*)q_proj;
#ifndef NO_ATTN0
            for (int p = vcu; p < 256; p += G) { const int vh = p >> 5, s = p & 31;
                const unsigned* nr = q_ctl + 16; const float qn = sqrtf(__uint_as_float(nr[2 * vh]) + __uint_as_float(nr[2 * vh + 1])), kn = sqrtf(__uint_as_float(nr[16 + 2 * vh]) + __uint_as_float(nr[16 + 2 * vh + 1]));
                const float thr = 2.04f * qn * kn + 40.f;
                for (int half = 0; half < 2; ++half) { const int qb = half ? 63 - s : s;
                    attn_body::attn_unit<0, 8>(qb, pj + (size_t)vh * M * 64, pj + (size_t)(8 + vh) * M * 64, pj + (size_t)(16 + vh) * M * 64, (abf*)q_yatt + vh * 64, q_cum + (size_t)vh * M, nullptr, thr, (char*)lds, wv); } }
#endif
#ifndef NO_ATTN1
            for (int p = 256 + vcu; p < 512; p += G) { const int d = (p >> 5) - 8, s = p & 31, hd = d >> 1, c = d & 1;
                for (int half = 0; half < 2; ++half) { const int qb = half ? 63 - s : s;
                    attn_body::attn_unit_d<8>(qb, pj + (size_t)(24 + d) * M * 64, pj + (size_t)(32 + d) * M * 64, pj + (size_t)5 * 512 * M + (size_t)hd * M * 128, (abf*)q_odiff + (size_t)c * M * 512 + hd * 128, nullptr, in[15] + hd, 0.f, (char*)lds, wv); } }
#endif
            if constexpr (REP_A > 1) {
#ifndef NO_DUP0
            for (int p = vcu; p < 256; p += G) { const int vh = p >> 5, s = p & 31;
                const unsigned* nr = q_ctl + 16; const float qn = sqrtf(__uint_as_float(nr[2 * vh]) + __uint_as_float(nr[2 * vh + 1])), kn = sqrtf(__uint_as_float(nr[16 + 2 * vh]) + __uint_as_float(nr[16 + 2 * vh + 1]));
                const float thr = 2.04f * qn * kn + 40.f;
                for (int half = 0; half < 2; ++half) { const int qb = half ? 63 - s : s;
                    attn_body::attn_unit<0, 8>(qb, pj + (size_t)vh * M * 64, pj + (size_t)(8 + vh) * M * 64, pj + (size_t)(16 + vh) * M * 64, (abf*)q_yatt + vh * 64, q_cum + (size_t)vh * M, nullptr, thr, (char*)lds, wv); } }
#endif
#ifndef NO_DUP1
            for (int p = 256 + vcu; p < 512; p += G) { const int d = (p >> 5) - 8, s = p & 31, hd = d >> 1, c = d & 1;
                for (int half = 0; half < 2; ++half) { const int qb = half ? 63 - s : s;
                    attn_body::attn_unit_d<8>(qb, pj + (size_t)(24 + d) * M * 64, pj + (size_t)(32 + d) * M * 64, pj + (size_t)5 * 512 * M + (size_t)hd * M * 128, (abf*)q_odiff + (size_t)c * M * 512 + hd * 128, nullptr, in[15] + hd, 0.f, (char*)lds, wv); } }
#endif
            }
        }
        GSYNC();

        PHASE(B + 2) {
            FRESH_IDS();
            const float lam_init = 0.8f - 0.6f * expf(-0.3f * (float)l);
            const float a1 = wave_sum(in[5][l * 64 + lane] * in[6][l * 64 + lane]), a2 = wave_sum(in[7][l * 64 + lane] * in[8][l * 64 + lane]);
            const float lam = expf(a1) - expf(a2) + lam_init;
            const float* sg = in[9] + l * 128 + (lane & 15) * 8; float gsc[8];
#pragma unroll
            for (int i = 0; i < 8; ++i) gsc[i] = sg[i] * (1.f - lam_init);
            const int gw = bx * NWAVES + wave, NGW = G * NWAVES;
            for (int row = gw; row < M; row += NGW) {
                const v4u a = *(const v4u*)(q_odiff + (size_t)row * 512 + 8 * lane), b = *(const v4u*)(q_odiff + (size_t)(M + row) * 512 + 8 * lane);
                float o[8]; const unsigned aw[4] = {a.x, a.y, a.z, a.w}, bw[4] = {b.x, b.y, b.z, b.w};
#pragma unroll
                for (int i = 0; i < 4; ++i) { o[2 * i] = pg8::bf_lo(aw[i]) - lam * pg8::bf_lo(bw[i]); o[2 * i + 1] = pg8::bf_hi(aw[i]) - lam * pg8::bf_hi(bw[i]); }
                float ss = 0.f;
#pragma unroll
                for (int i = 0; i < 8; ++i) ss += o[i] * o[i];
                ss += shx(ss, 1); ss += shx(ss, 2); ss += shx(ss, 4); ss += shx(ss, 8);
                const float r = 1.f / sqrtf(ss * (1.f / 128.f) + SUBLN_EPS);
                v4u w; w.x = pk2(o[0] * r * gsc[0], o[1] * r * gsc[1]); w.y = pk2(o[2] * r * gsc[2], o[3] * r * gsc[3]); w.z = pk2(o[4] * r * gsc[4], o[5] * r * gsc[5]); w.w = pk2(o[6] * r * gsc[6], o[7] * r * gsc[7]);
                *(v4u*)(q_yatt + (size_t)(M + row) * 512 + 8 * lane) = w;
            }
        }
        GSYNC();

        PHASE(B + 3) {
            pg8::Gemm g{q_yatt, q_Wbr_t + (size_t)l * 2048 * 512, 2 * M, 2048, 512}; pg8::MergeOrder S; S.b.init(M, 1024, G, bx);
            pg8::EpiMerge E{q_proj, q_Tb, q_merged};
            if (PHM & (1u << 2)) GEMM_PHASE(pg8::EpiMerge, pg8::MergeOrder, g, S, E);
        }
        GSYNC();
        PHASE(B + 4) {
            pg8::Gemm g{q_merged, q_Wo_t + (size_t)l * 1024 * 1024, M, 1024, 1024}; pg8::StaticOrder S; S.init(M, 1024, G, bx);
            pg8::EpiResid E{l == 0 ? pg8::PrevLN{in[0], q_stats, in[1], in[2]} : pg8::PrevLN{q_z, q_stats, in[21], in[22]}, q_z, ALPHA, 1.f};
            if (PHM & (1u << 3)) GEMM_PHASE(pg8::EpiResid, pg8::StaticOrder, g, S, E);
        }
        GSYNC();
        PHASE(B + 5) {
        if constexpr (l == 0) { if (PHM & (1u << 12)) ln_phase<0, 0, (DENSE_FP8 != 0)>(ldsp, G, q_z, pg8::PrevLN{nullptr, nullptr, nullptr, nullptr}, nullptr, nullptr, nullptr, nullptr, nullptr, in[13], in[14], nullptr, q_stats, q_hb, nullptr, 0, nullptr, nullptr, nullptr, nullptr, nullptr, wv); }
        else { if (PHM & (1u << 13)) ln_phase<0, 2>(ldsp, G, q_z, pg8::PrevLN{nullptr, nullptr, nullptr, nullptr}, nullptr, nullptr, nullptr, nullptr, nullptr, in[13] + 1024, in[14] + 1024, nullptr, q_stats, q_hb, in[18], 8, nullptr, nullptr, q_eidx, q_gwt, q_ctl, wv); }
        }
        GSYNC();

        if constexpr (l == 0) {
            PHASE(B + 6) {
                pg8::StaticOrder S; S.init(M, 2 * DFF, G, bx);
                if constexpr (DENSE_FP8 == 0) { pg8::Gemm g{q_hb, q_Wgu_t, M, 2 * DFF, 1024}; pg8::EpiSwiglu E{q_act, DFF, 1 << 20, 1.f}; if (PHM & (1u << 4)) GEMM_PHASE(pg8::EpiSwiglu, pg8::StaticOrder, g, S, E); }
                else if constexpr (DENSE_FP8 == 1) { pg8::Gemm g{q_hb, q_Wgu_t, M, 2 * DFF, 512}; pg8::EpiSwiglu E{q_act, DFF, 1 << 20, 1.f / W8_SCALE}; GEMM_PHASE8(pg8::EpiSwiglu, pg8::StaticOrder, g, S, E); }
                else { pg8::Gemm g{q_hb, q_Wgu_t, M, 2 * DFF, 512}; pg8::EpiSwiglu8 E{(unsigned char*)q_act, DFF, 1 << 20, 1.f / W8_SCALE, A8_SCALE}; GEMM_PHASE8(pg8::EpiSwiglu8, pg8::StaticOrder, g, S, E); }
            }
            GSYNC();
            PHASE(B + 7) {
                pg8::StaticOrder S; S.init(M, 1024, G, bx);
                if constexpr (DENSE_FP8 == 2) { pg8::Gemm g{q_act, q_Wdn_t, M, 1024, DFF / 2}; pg8::EpiResid E{pg8::PrevLN{q_z, q_stats, in[13], in[14]}, q_z, ALPHA, 1.f / (W8_SCALE * A8_SCALE)}; GEMM_PHASE8(pg8::EpiResid, pg8::StaticOrder, g, S, E); }
                else { pg8::Gemm g{q_act, q_Wdn_t, M, 1024, DFF}; pg8::EpiResid E{pg8::PrevLN{q_z, q_stats, in[13], in[14]}, q_z, ALPHA, 1.f}; if (PHM & (1u << 5)) GEMM_PHASE(pg8::EpiResid, pg8::StaticOrder, g, S, E); }
            }
            GSYNC();
            PHASE(B + 8) if (PHM & (1u << 14)) ln_phase<0, 1>(ldsp, G, q_z, pg8::PrevLN{nullptr, nullptr, nullptr, nullptr}, nullptr, nullptr, nullptr, nullptr, nullptr, in[21], in[22], nullptr, q_stats, q_hb, in[3] + (size_t)1024 * NIN + 1536, NIN, in[4] + 8, q_logf, nullptr, nullptr, nullptr, wv);
            GSYNC();
        } else {
            PHASE(B + 6) {
                FRESH_IDS();
                LAS int* li = (LAS int*)ldsp;
                if (tid < 8) { li[tid] = 0; li[32 + tid] = (int)q_ctl[tid]; }
                __syncthreads();
                if (tid == 0) { int o = 0; for (int e = 0; e < 8; ++e) { li[16 + e] = o; o += (li[32 + e] + 255) & ~255; } li[24] = o; }
                __syncthreads();
                const int npad_rows = li[24];
                if (bx == 0) { for (int t = tid; t < 240; t += NT) { int e = 0; for (int q = 1; q < 8; ++q) if (t * 256 >= li[16 + q]) e = q; q_tile_e[t] = e; } if (tid == 0) q_tile_e[255] = npad_rows / 256; }
                for (int tb = bx * 64; tb < M; tb += G * 64) {
                    int e = 0, r = 0, tok = 0;
                    if (tid < 128) { tok = tb + (tid >> 1); const int ei = q_eidx[tok]; e = (tid & 1) ? (ei >> 8) & 0xff : ei & 0xff; r = atomicAdd((int*)&li[e], 1); }
                    __syncthreads();
                    if (tid < 8) { li[8 + tid] = (int)atomicAdd(q_ctl + 8 + tid, (unsigned)li[tid]); }
                    __syncthreads();
                    if (tid < 128) { const int p = li[16 + e] + li[8 + e] + r; q_pos[2 * tok + (tid & 1)] = p; ((LAS int*)ldsp)[64 + tid] = p; }
                    __syncthreads();
                    if (tid < 8) li[tid] = 0;
                    for (int sidx = wave; sidx < 128; sidx += NWAVES) { const int p = ((LAS int*)ldsp)[64 + sidx]; const int tk = tb + (sidx >> 1);
                        { const v4u a = *(const v4u*)(q_hb + (size_t)tk * 1024 + 16 * lane), b = *(const v4u*)(q_hb + (size_t)tk * 1024 + 16 * lane + 8); v4u o; int w;
                            w = 0; w = __builtin_amdgcn_cvt_pk_fp8_f32(pg8::bf_lo(a.x), pg8::bf_hi(a.x), w, false); w = __builtin_amdgcn_cvt_pk_fp8_f32(pg8::bf_lo(a.y), pg8::bf_hi(a.y), w, true); o.x = (unsigned)w;
                            w = 0; w = __builtin_amdgcn_cvt_pk_fp8_f32(pg8::bf_lo(a.z), pg8::bf_hi(a.z), w, false); w = __builtin_amdgcn_cvt_pk_fp8_f32(pg8::bf_lo(a.w), pg8::bf_hi(a.w), w, true); o.y = (unsigned)w;
                            w = 0; w = __builtin_amdgcn_cvt_pk_fp8_f32(pg8::bf_lo(b.x), pg8::bf_hi(b.x), w, false); w = __builtin_amdgcn_cvt_pk_fp8_f32(pg8::bf_lo(b.y), pg8::bf_hi(b.y), w, true); o.z = (unsigned)w;
                            w = 0; w = __builtin_amdgcn_cvt_pk_fp8_f32(pg8::bf_lo(b.z), pg8::bf_hi(b.z), w, false); w = __builtin_amdgcn_cvt_pk_fp8_f32(pg8::bf_lo(b.w), pg8::bf_hi(b.w), w, true); o.w = (unsigned)w;
                            *(v4u*)((unsigned char*)q_Xs + (size_t)p * 1024 + 16 * lane) = o; } }
                    __syncthreads();
                }
                if (bx == 0) {
                    const int nMt = npad_rows / 256, nwg = nMt * 4, lim = pg8::main_units(nwg, G); int* tl = q_tile_e + 8192;
                    pg8::i32x4* tm = (pg8::i32x4*)(q_tile_e + 1024); pg8::i32x4* tt = (pg8::i32x4*)(q_tile_e + 4096);
                    for (int t = tid; t < nwg; t += NT) tl[t] = -1;
                    __syncthreads();
                    for (int L = tid; L < nwg; L += NT) { pg8::Unit u; pg8::map_unit(L, nMt, 4, u); int e = 0; for (int q = 1; q < 8; ++q) if (u.pm * 256 >= li[16 + q]) e = q;
                        if (L < lim) tm[L] = (pg8::i32x4){u.pm, u.pn + 4 * e, 0, 0};
                        else { tl[u.pm * 4 + u.pn] = L - lim; for (int sl = 0; sl < pg8::TAIL_KS; ++sl) tt[(L - lim) * pg8::TAIL_KS + sl] = (pg8::i32x4){u.pm, u.pn + 4 * e, sl * pg8::TAIL_K, (L - lim) * pg8::TAIL_KS + sl}; } }
                    if (tid == 0) { q_tile_e[254] = lim; q_tile_e[253] = (nwg - lim) * pg8::TAIL_KS; }
                }
                for (int e = 0; e < 8; ++e) { const int c = li[32 + e], st = li[16 + e] + c, en = li[16 + e] + ((c + 255) & ~255);
                    for (int rr = st + bx * NWAVES + wave; rr < en; rr += G * NWAVES) {
                        *(v4u*)((unsigned char*)q_Xs + (size_t)rr * 1024 + 16 * lane) = (v4u){0u, 0u, 0u, 0u}; } }
            }
            GSYNC();
            PHASE(B + 7) {
                const int mrows = __builtin_amdgcn_readfirstlane(q_tile_e[255]) * 256;
                pg8::Gemm g{q_Xs, q_Wegu_t, mrows, 2 * DFFE, 512}; pg8::MoeOrder S; S.b.init(mrows, 2 * DFFE, G, bx); S.te = q_tile_e; S.nper = 28;
                pg8::EpiSwiglu8 E{(unsigned char*)q_acts, DFFE, 28, 1.f / W8_SCALE, A8_SCALE};
                if (PHM & (1u << 6)) GEMM_PHASE8(pg8::EpiSwiglu8, pg8::MoeOrder, g, S, E);
            }
            GSYNC();
            PHASE(B + 8) {
                const int mrows = __builtin_amdgcn_readfirstlane(q_tile_e[255]) * 256, lim = __builtin_amdgcn_readfirstlane(q_tile_e[254]), nsub = __builtin_amdgcn_readfirstlane(q_tile_e[253]);
                {
                    pg8::Gemm g{q_acts, q_Wedn_t, mrows, 1024, DFFE / 2}; pg8::TableOrder S{(const pg8::i32x4*)(q_tile_e + 1024), lim, G, bx};
                    pg8::EpiStoreF32 E{q_ys, 4, 1.f / (W8_SCALE * A8_SCALE)};
                    if (PHM & (1u << 7)) GEMM_PHASE8(pg8::EpiStoreF32, pg8::TableOrder, g, S, E);
                }
                if (nsub > 0) {
                    pg8::Gemm g{q_acts, q_Wedn_t, mrows, 1024, pg8::TAIL_K, DFFE / 2}; pg8::TableOrder S{(const pg8::i32x4*)(q_tile_e + 4096), nsub, G, bx};
                    pg8::EpiStoreTail E{q_h, 1.f / (W8_SCALE * A8_SCALE)};
                    GEMM_PHASE8(pg8::EpiStoreTail, pg8::TableOrder, g, S, E);
                }
            }
            GSYNC();
            PHASE(B + 9) if (PHM & (1u << 15)) ln_phase<1, 0>(ldsp, G, nullptr, pg8::PrevLN{q_z, q_stats, in[13] + 1024, in[14] + 1024}, q_ys, q_pos, q_gwt, q_tile_e + 8192, q_h, in[21] + 1024, in[22] + 1024, karg_out(), nullptr, nullptr, nullptr, 0, nullptr, nullptr, nullptr, nullptr, nullptr, wv);
        }
}

template <int SEL> __global__ void __launch_bounds__(NWAVES * 64, 2) fwd_kernel(Args args) {
    extern __shared__ __attribute__((aligned(16))) unsigned char lds[];
    LAS unsigned char* ldsp = (LAS unsigned char*)lds;
    const int G = gridDim.x, bx = blockIdx.x; const int vcu = (G % 8 == 0) ? (bx % 8) * (G / 8) + bx / 8 : bx;
    const int wv = __builtin_amdgcn_readfirstlane((int)threadIdx.x >> 6);
    if constexpr (SEL < 0) { const int t0_ = mk_tid(wv); if (t0_ < 2) ((volatile LAS unsigned*)(ldsp + attn_body::LDS_BYTES))[t0_] = 0u; __syncthreads();
        (void)xcd_barrier_post((unsigned*)(karg_ws() + WS_BAR), (volatile LAS unsigned*)(ldsp + attn_body::LDS_BYTES), wv); }
    PHASE(0) {
        FRESH_IDS();
        LAS float* scr = (LAS float*)(ldsp + wave * 16384);
        const int gw = vcu * NWAVES + wave, NGW = G * NWAVES;
        constexpr int I_A = 16 * 48, I_B = 16 * 112, I_BR = 8 * 32, I_O = 16 * 32, I_L = I_A + I_B + 2 * I_BR + I_O;
        constexpr int I_GU = 16 * 176, I_DN = 44 * 32, I_EGU = 16 * 224, I_EDN = 56 * 32;
        constexpr int NITEMS = 2 * I_L + I_GU + I_DN + 8 * I_EGU + 8 * I_EDN;
        _Pragma("nounroll") for (int repp_ = 0; repp_ < REP_P; ++repp_)
        for (int it = gw; it < NITEMS; it += NGW) {
            int r = it;
            if (r < 2 * I_L) { const int l = r / I_L; r -= l * I_L; const float* win = in[3] + (size_t)l * 1024 * NIN; bf16* wt = q_Win_t + (size_t)l * NPROJ * 1024;
                if (r < I_A) { tr_seg<0>(win, NIN, 1024, 0, 1536, wt, 0, 0, scr, r, lane); continue; } r -= I_A;
                if (r < I_B) { tr_seg<0>(win, NIN, 1024, 1544, 3584, wt, 1536, 0, scr, r, lane); continue; } r -= I_B;
                if (r < I_BR) { tr_seg<0>(in[10] + (size_t)l * 512 * 1024, 1024, 512, 0, 1024, q_Wbr_t + (size_t)l * 2048 * 512, 0, 0, scr, r, lane); continue; } r -= I_BR;
                if (r < I_BR) { tr_seg<0>(in[11] + (size_t)l * 512 * 1024, 1024, 512, 0, 1024, q_Wbr_t + (size_t)l * 2048 * 512, 1024, 0, scr, r, lane); continue; } r -= I_BR;
                tr_seg<0>(in[12] + (size_t)l * 1024 * 1024, 1024, 1024, 0, 1024, q_Wo_t + (size_t)l * 1024 * 1024, 0, 0, scr, r, lane); continue; }
            r -= 2 * I_L;
            if (r < I_GU) { if constexpr (DENSE_FP8 != 0) tr_seg8<1>(in[16], 2 * DFF, 1024, 0, 2 * DFF, (unsigned char*)q_Wgu_t, 0, DFF, W8_SCALE, scr, r, lane); else tr_seg<1>(in[16], 2 * DFF, 1024, 0, 2 * DFF, q_Wgu_t, 0, DFF, scr, r, lane); continue; } r -= I_GU;
            if (r < I_DN) { if constexpr (DENSE_FP8 == 2) tr_seg8<0>(in[17], 1024, DFF, 0, 1024, (unsigned char*)q_Wdn_t, 0, 0, W8_SCALE, scr, r, lane); else tr_seg<0>(in[17], 1024, DFF, 0, 1024, q_Wdn_t, 0, 0, scr, r, lane); continue; } r -= I_DN;
            if (r < 8 * I_EGU) { const int e = r / I_EGU; r -= e * I_EGU; tr_seg8<1>(in[19] + (size_t)e * 1024 * 2 * DFFE, 2 * DFFE, 1024, 0, 2 * DFFE, (unsigned char*)q_Wegu_t + (size_t)e * 2 * DFFE * 1024, 0, DFFE, W8_SCALE, scr, r, lane); continue; } r -= 8 * I_EGU;
            { const int e = r / I_EDN; r -= e * I_EDN; tr_seg8<0>(in[20] + (size_t)e * DFFE * 1024, 1024, DFFE, 0, 1024, (unsigned char*)q_Wedn_t + (size_t)e * 1024 * DFFE, 0, 0, W8_SCALE, scr, r, lane); }
        }
        __syncthreads();
        if (PHM & (1u << 11)) ln_phase<0, 1>(ldsp, G, in[0], pg8::PrevLN{nullptr, nullptr, nullptr, nullptr}, nullptr, nullptr, nullptr, nullptr, nullptr, in[1], in[2], nullptr, q_stats, q_hb, in[3] + 1536, NIN, in[4], q_logf, nullptr, nullptr, nullptr, wv);
    }
    GSYNC_CG();

    layer_body<0, SEL>(args, ldsp, lds, G, bx, vcu, wv);
    layer_body<1, SEL>(args, ldsp, lds, G, bx, vcu, wv);
}

#undef q_ctl
#undef q_logf
#undef q_cum
#undef q_eidx
#undef q_gwt
#undef q_pos
#undef q_tile_e
#undef q_Win_t
#undef q_Wbr_t
#undef q_Wo_t
#undef q_Wgu_t
#undef q_Wdn_t
#undef q_Wegu_t
#undef q_Wedn_t
#undef q_h
#undef q_stats
#undef q_hb
#undef q_proj
#undef q_yatt
#undef q_odiff
#undef q_Tb
#undef q_merged
#undef q_z
#undef q_act
#undef q_Xs
#undef q_acts
#undef q_ys
#undef in
#ifndef N_LAUNCH_MODE
#define N_LAUNCH_MODE 0
#endif
template <int S> static void launch_sel(int grid, Args& a, hipStream_t stream) {
    static bool attr = false;
    if (!attr) { (void)hipFuncSetAttribute((const void*)fwd_kernel<S>, hipFuncAttributeMaxDynamicSharedMemorySize, LDS_BYTES); attr = true; }
    hipLaunchKernelGGL(fwd_kernel<S>, dim3(grid), dim3(NWAVES * 64), LDS_BYTES, stream, a);
}
template <int S> static void launch_all(int grid, Args& a, hipStream_t stream) {
    if constexpr (S <= 20) { if constexpr (S != 10) launch_sel<S>(grid, a, stream); launch_all<S + 1>(grid, a, stream); }
}
extern "C" void kernel_launch(void* const* d_in, const int* in_sizes, int n_in, void* d_out, int out_size, void* d_ws, size_t ws_size, hipStream_t stream) {
    static int grid = 0;
    if (grid == 0) {
        if (n_in != 23 || out_size != M * DMODEL || ws_size < WS_END) { fprintf(stderr, "kernel_launch: unexpected shapes (n_in %d, out %d, ws %zu)\n", n_in, out_size, ws_size); grid = -1; return; }
        int dev = 0, cus = 0;
        (void)hipGetDevice(&dev); (void)hipDeviceGetAttribute(&cus, hipDeviceAttributeMultiprocessorCount, dev);
#if N_LAUNCH_MODE == 0
        int per_cu = 0;
        if (hipFuncSetAttribute((const void*)fwd_kernel<-1>, hipFuncAttributeMaxDynamicSharedMemorySize, LDS_BYTES) != hipSuccess) { fprintf(stderr, "kernel_launch: hipFuncSetAttribute failed\n"); grid = -1; return; }
        if (hipOccupancyMaxActiveBlocksPerMultiprocessor(&per_cu, (const void*)fwd_kernel<-1>, NWAVES * 64, LDS_BYTES) != hipSuccess || per_cu < 1) { fprintf(stderr, "kernel_launch: occupancy query says %d\n", per_cu); }
        (void)hipGetLastError();
#endif
        grid = cus;
    }
    if (grid < 0) return;
    (void)hipMemsetAsync((char*)d_ws + WS_CTL, 0, 32768, stream);
    Args a{};
    for (int i = 0; i < 23; ++i) a.in[i] = (const float*)d_in[i];
    a.out = (float*)d_out; a.ws = (unsigned char*)d_ws;
#if N_LAUNCH_MODE == 0
    void* kargs[] = {&a};
    hipError_t e = hipLaunchCooperativeKernel((const void*)fwd_kernel<-1>, dim3(grid), dim3(NWAVES * 64), kargs, LDS_BYTES, stream);
    if (e != hipSuccess) fprintf(stderr, "cooperative launch failed: %s (grid %d)\n", hipGetErrorString(e), grid);
#else
    launch_all<0>(grid, a, stream);
#endif
}
```
